# Optimizing an MI355X kernel written in HIP

```python
import jax, jax.numpy as jnp
from jax import lax
import numpy as np

D_MODEL = 2048
BATCH = 4
SEQ = 8192
DEPTH = 1

GRID_W = 64
ROPE_THETA = 10000.0
Q_BLOCK = 128
HEAD_DIM = 128
GQA_Q_HEADS = 8
GQA_KV_HEADS = 2
MLA_HEADS = 8
MLA_Q_RANK = 512
MLA_KV_RANK = 512
MLA_NOPE_DIM = 128
MLA_ROPE_DIM = 64
MLA_V_DIM = 128
N_BRANCHES = 2
D_FF = ((8 * D_MODEL + 3 * 256 - 1) // (3 * 256)) * 256
DEEPNORM_ALPHA = (2.0 * DEPTH) ** 0.25
DEEPNORM_BETA = (8.0 * DEPTH) ** -0.25
LN_EPS = 1e-5
RMS_EPS = 1e-6

GQA_Q_COLS = GQA_Q_HEADS * HEAD_DIM
GQA_KV_COLS = GQA_KV_HEADS * HEAD_DIM
GATE_COLS = N_BRANCHES * D_MODEL
IN_SIZES = [GQA_Q_COLS, GQA_KV_COLS, GQA_KV_COLS, MLA_Q_RANK, MLA_KV_RANK, MLA_ROPE_DIM, GATE_COLS]
IN_SPLITS = list(np.cumsum(IN_SIZES)[:-1].tolist())
IN_COLS = sum(IN_SIZES)

kernel_name = "hybrid_gqa_mla_gated_deepnorm_encoder"


def layer_norm(x):
    xf = x.astype(jnp.float32)
    mu = jnp.mean(xf, axis=-1, keepdims=True)
    var = jnp.mean(jnp.square(xf - mu), axis=-1, keepdims=True)
    return ((xf - mu) * lax.rsqrt(var + LN_EPS)).astype(x.dtype)


def layer_norm_affine(x, g, b):
    xf = x.astype(jnp.float32)
    mu = jnp.mean(xf, axis=-1, keepdims=True)
    var = jnp.mean(jnp.square(xf - mu), axis=-1, keepdims=True)
    y = (xf - mu) * lax.rsqrt(var + LN_EPS) * g.astype(jnp.float32) + b.astype(jnp.float32)
    return y.astype(x.dtype)


def rms_norm(x, g):
    xf = x.astype(jnp.float32)
    y = xf * lax.rsqrt(jnp.mean(jnp.square(xf), axis=-1, keepdims=True) + RMS_EPS) * g.astype(jnp.float32)
    return y.astype(x.dtype)


def modulate(h, shift, scale):
    return h * (1.0 + scale) + shift


def axial_rope_tables(seq, dim):
    rows = seq // GRID_W
    quarter = dim // 4
    inv_freq = ROPE_THETA ** (-jnp.arange(quarter, dtype=jnp.float32) / quarter)
    row_ang = jnp.arange(rows, dtype=jnp.float32)[:, None] * inv_freq
    col_ang = jnp.arange(GRID_W, dtype=jnp.float32)[:, None] * inv_freq
    ang = jnp.concatenate([
        jnp.broadcast_to(row_ang[:, None, :], (rows, GRID_W, quarter)),
        jnp.broadcast_to(col_ang[None, :, :], (rows, GRID_W, quarter)),
    ], axis=-1).reshape(seq, 2 * quarter)
    return jnp.cos(ang), jnp.sin(ang)


def apply_rope(x, cos, sin):
    xf = x.astype(jnp.float32).reshape(*x.shape[:-1], x.shape[-1] // 2, 2)
    x0, x1 = xf[..., 0], xf[..., 1]
    c = cos[None, :, None, :]
    s = sin[None, :, None, :]
    out = jnp.stack([x0 * c - x1 * s, x0 * s + x1 * c], axis=-1).reshape(x.shape)
    return out.astype(x.dtype)


def gqa_attention(q, k, v):
    b, s, hq, d = q.shape
    hkv = k.shape[2]
    g = hq // hkv
    nb = s // Q_BLOCK
    qb = q.reshape(b, nb, Q_BLOCK, hkv, g, d).transpose(1, 0, 2, 3, 4, 5)
    scale = d ** -0.5

    def block(q_blk):
        sc = jnp.einsum('bqkgd,bskd->bkgqs', q_blk, k, preferred_element_type=jnp.float32) * scale
        p = jax.nn.softmax(sc, axis=-1).astype(v.dtype)
        return jnp.einsum('bkgqs,bskd->bqkgd', p, v)

    out = lax.map(block, qb)
    return out.transpose(1, 0, 2, 3, 4, 5).reshape(b, s, hq * d)


def mla_attention(q_nope, q_rope, k_nope, k_rope, v):
    b, s, h, dn = q_nope.shape
    dr = q_rope.shape[-1]
    dv = v.shape[-1]
    nb = s // Q_BLOCK
    qn = q_nope.reshape(b, nb, Q_BLOCK, h, dn).transpose(1, 0, 2, 3, 4)
    qr = q_rope.reshape(b, nb, Q_BLOCK, h, dr).transpose(1, 0, 2, 3, 4)
    scale = (dn + dr) ** -0.5

    def block(args):
        qn_blk, qr_blk = args
        sc = (jnp.einsum('bqhd,bshd->bhqs', qn_blk, k_nope, preferred_element_type=jnp.float32)
              + jnp.einsum('bqhr,bsr->bhqs', qr_blk, k_rope, preferred_element_type=jnp.float32)) * scale
        p = jax.nn.softmax(sc, axis=-1).astype(v.dtype)
        return jnp.einsum('bhqs,bshd->bqhd', p, v)

    out = lax.map(block, (qn, qr))
    return out.transpose(1, 0, 2, 3, 4).reshape(b, s, h * dv)


def _normal(k, shape, fan_in, gain=1.0):
    return jax.random.normal(k, shape, jnp.float32) * (gain * fan_in ** -0.5)


def _gain(k, shape):
    return 1.0 + 0.02 * jax.random.normal(k, shape, jnp.float32)


def setup_inputs(seed: int = 0) -> dict:
    key = jax.random.key(seed)
    ks = jax.random.split(key, 24)
    L, D = DEPTH, D_MODEL
    x = jax.random.normal(ks[0], (BATCH, SEQ, D), jnp.float32)
    c = jax.random.normal(ks[1], (BATCH, D), jnp.float32)
    w_ada = _normal(ks[2], (L, D, 6 * D), D, 0.5)
    b_ada = 0.02 * jax.random.normal(ks[3], (L, 6 * D), jnp.float32)
    col_scale = jnp.concatenate([
        jnp.ones((GQA_Q_COLS + GQA_KV_COLS,), jnp.float32),
        jnp.full((GQA_KV_COLS,), DEEPNORM_BETA, jnp.float32),
        jnp.ones((MLA_Q_RANK + MLA_KV_RANK + MLA_ROPE_DIM + GATE_COLS,), jnp.float32),
    ])
    w_in = _normal(ks[4], (L, D, IN_COLS), D) * col_scale
    b_gates = 0.01 * jax.random.normal(ks[5], (L, GATE_COLS), jnp.float32)
    gqa_q_gain = _gain(ks[6], (L, HEAD_DIM))
    gqa_k_gain = _gain(ks[7], (L, HEAD_DIM))
    mla_q_gain = _gain(ks[8], (L, MLA_Q_RANK))
    mla_kv_gain = _gain(ks[9], (L, MLA_KV_RANK))
    w_mla_uq = _normal(ks[10], (L, MLA_Q_RANK, MLA_HEADS * (MLA_NOPE_DIM + MLA_ROPE_DIM)), MLA_Q_RANK)
    w_uk = _normal(ks[11], (L, MLA_KV_RANK, MLA_HEADS, MLA_NOPE_DIM), MLA_KV_RANK)
    w_uv = _normal(ks[12], (L, MLA_KV_RANK, MLA_HEADS, MLA_V_DIM), MLA_KV_RANK, DEEPNORM_BETA)
    w_mla_ukv = jnp.concatenate([w_uk, w_uv], axis=-1).reshape(L, MLA_KV_RANK, MLA_HEADS * (MLA_NOPE_DIM + MLA_V_DIM))
    w_branch_gqa = _normal(ks[13], (L, GQA_Q_COLS, D), GQA_Q_COLS, DEEPNORM_BETA)
    w_branch_mla = _normal(ks[14], (L, MLA_HEADS * MLA_V_DIM, D), MLA_HEADS * MLA_V_DIM, DEEPNORM_BETA)
    w_out = _normal(ks[15], (L, D, D), D, DEEPNORM_BETA)
    ln1_g = _gain(ks[16], (L, D))
    ln1_b = 0.02 * jax.random.normal(ks[17], (L, D), jnp.float32)
    w_ffn_gate = _normal(ks[18], (L, D, D_FF), D, DEEPNORM_BETA)
    w_ffn_up = _normal(ks[19], (L, D, D_FF), D, DEEPNORM_BETA)
    w_ffn_down = _normal(ks[20], (L, D_FF, D), D_FF, DEEPNORM_BETA)
    ln2_g = _gain(ks[21], (L, D))
    ln2_b = 0.02 * jax.random.normal(ks[22], (L, D), jnp.float32)
    return {
        "x": x, "c": c, "w_ada": w_ada, "b_ada": b_ada, "w_in": w_in, "b_gates": b_gates,
        "gqa_q_gain": gqa_q_gain, "gqa_k_gain": gqa_k_gain, "mla_q_gain": mla_q_gain,
        "mla_kv_gain": mla_kv_gain, "w_mla_uq": w_mla_uq, "w_mla_ukv": w_mla_ukv,
        "w_branch_gqa": w_branch_gqa, "w_branch_mla": w_branch_mla, "w_out": w_out,
        "ln1_g": ln1_g, "ln1_b": ln1_b, "w_ffn_gate": w_ffn_gate, "w_ffn_up": w_ffn_up,
        "w_ffn_down": w_ffn_down, "ln2_g": ln2_g, "ln2_b": ln2_b,
    }


def reference(x, c, w_ada, b_ada, w_in, b_gates, gqa_q_gain, gqa_k_gain, mla_q_gain, mla_kv_gain,
              w_mla_uq, w_mla_ukv, w_branch_gqa, w_branch_mla, w_out, ln1_g, ln1_b,
              w_ffn_gate, w_ffn_up, w_ffn_down, ln2_g, ln2_b):
    b, s, _ = x.shape
    cos_g, sin_g = axial_rope_tables(s, HEAD_DIM)
    cos_m, sin_m = axial_rope_tables(s, MLA_ROPE_DIM)
    c_act = jax.nn.silu(c)
    for l in range(DEPTH):
        mod = (c_act @ w_ada[l] + b_ada[l])[:, None, :]
        shift1, scale1, gate1, shift2, scale2, gate2 = jnp.split(mod, 6, axis=-1)

        h = modulate(layer_norm(x), shift1, scale1)
        proj = h @ w_in[l]
        q_g, k_g, v_g, q_lat, kv_lat, k_r, gate_logits = jnp.split(proj, IN_SPLITS, axis=-1)

        q_g = apply_rope(rms_norm(q_g.reshape(b, s, GQA_Q_HEADS, HEAD_DIM), gqa_q_gain[l]), cos_g, sin_g)
        k_g = apply_rope(rms_norm(k_g.reshape(b, s, GQA_KV_HEADS, HEAD_DIM), gqa_k_gain[l]), cos_g, sin_g)
        v_g = v_g.reshape(b, s, GQA_KV_HEADS, HEAD_DIM)
        y_gqa = gqa_attention(q_g, k_g, v_g)

        q_m = (rms_norm(q_lat, mla_q_gain[l]) @ w_mla_uq[l]).reshape(b, s, MLA_HEADS, MLA_NOPE_DIM + MLA_ROPE_DIM)
        q_nope = q_m[..., :MLA_NOPE_DIM]
        q_rope = apply_rope(q_m[..., MLA_NOPE_DIM:], cos_m, sin_m)
        kv = (rms_norm(kv_lat, mla_kv_gain[l]) @ w_mla_ukv[l]).reshape(b, s, MLA_HEADS, MLA_NOPE_DIM + MLA_V_DIM)
        k_nope = kv[..., :MLA_NOPE_DIM]
        v_m = kv[..., MLA_NOPE_DIM:]
        k_rope = apply_rope(k_r[:, :, None, :], cos_m, sin_m)[:, :, 0, :]
        y_mla = mla_attention(q_nope, q_rope, k_nope, k_rope, v_m)

        g_gqa, g_mla = jnp.split(jax.nn.sigmoid(gate_logits + b_gates[l]), N_BRANCHES, axis=-1)
        merged = g_gqa * (y_gqa @ w_branch_gqa[l]) + g_mla * (y_mla @ w_branch_mla[l])
        x = layer_norm_affine(DEEPNORM_ALPHA * x + gate1 * (merged @ w_out[l]), ln1_g[l], ln1_b[l])

        h = modulate(layer_norm(x), shift2, scale2)
        f = (jax.nn.silu(h @ w_ffn_gate[l]) * (h @ w_ffn_up[l])) @ w_ffn_down[l]
        x = layer_norm_affine(DEEPNORM_ALPHA * x + gate2 * f, ln2_g[l], ln2_b[l])
    return x
```

```cpp
#include <hip/hip_runtime.h>
#include <hip/hip_cooperative_groups.h>
#include <hip/hip_bf16.h>
#include <cstdio>
#include <cstdint>
namespace cg = cooperative_groups;

#ifndef PROBE_P0
#define PROBE_P0 1
#endif
#ifndef PROBE_P1
#define PROBE_P1 1
#endif
#ifndef PROBE_GEMM
#define PROBE_GEMM 1
#endif
#ifndef PROBE_REP10
#define PROBE_REP10 1
#endif
#ifndef PROBE_REP6
#define PROBE_REP6 1
#endif
#ifndef MK_PER_PHASE
#define MK_PER_PHASE 0
#endif

constexpr int DM = 2048, NB = 4, SEQ = 8192, M = NB * SEQ;
constexpr int NPROJ = 6912;
constexpr int DFF = 5632;
constexpr float LN_EPS = 1e-5f, RMS_EPS = 1e-6f;
constexpr float ALPHA = 1.189207115002721f;
constexpr float CG_PRE = 0.088388347648318440f * 1.4426950408889634f;
constexpr float CM_PRE = 0.072168783648703220f * 1.4426950408889634f;
constexpr int PC_QG = 0, PC_KG = 1024, PC_VG = 1280, PC_QLAT = 1536, PC_KVLAT = 2048, PC_GATE = 2560, PC_KR = 6656;

constexpr size_t MiB = 1u << 20;
constexpr size_t WS_CTL = 0;
constexpr size_t WS_MOD = 1 * MiB;
constexpr size_t WS_TAB = 2 * MiB;
constexpr size_t WS_RINV = 3 * MiB;
constexpr size_t WS_WIN = 16 * MiB, WS_WUQ = 43 * MiB, WS_WUKV = 45 * MiB, WS_WBG = 47 * MiB, WS_WBM = 51 * MiB, WS_WOUT = 55 * MiB, WS_WGU = 63 * MiB, WS_WDN = 107 * MiB;
constexpr size_t WS_H = 130 * MiB;
constexpr size_t WS_PROJ = 258 * MiB;
constexpr size_t WS_KV = 690 * MiB;
constexpr size_t WS_YATT = 818 * MiB;
constexpr size_t WS_END = 946 * MiB;

__device__ __forceinline__ int mk_lane_id() { int l; asm volatile("v_mbcnt_lo_u32_b32 %0, -1, 0\n\tv_mbcnt_hi_u32_b32 %0, -1, %0" : "=&v"(l)); return l; }
namespace pg8 {
#define PG8_LAS __attribute__((address_space(3)))
typedef unsigned short bf16_t;
typedef short bf16x8 __attribute__((ext_vector_type(8)));
typedef float f32x4 __attribute__((ext_vector_type(4)));
typedef unsigned u32x4 __attribute__((ext_vector_type(4)));
constexpr int BM = 256, BK = 64, HALF = 128, HTB = HALF * BK * 2, STAGE_BYTES = 8 * HTB, NXCD = 8, WGM = 8;

__host__ __device__ __forceinline__ int lds_byte(int r, int c) { const int st = (r >> 4) * 2 + (c >> 5), rr = r & 15, cc = c & 31, ob = rr * 64 + cc * 2; return st * 1024 + (ob ^ (((ob >> 9) & 1) << 5)); }
__host__ __device__ __forceinline__ void stage_rc(int b, int& R, int& C) { const int st = b / 1024, sb = b % 1024, swz = sb ^ (((sb >> 9) & 1) << 5); R = (st >> 1) * 16 + swz / 64; C = (st & 1) * 32 + (swz % 64) / 2; }
__host__ __device__ __forceinline__ int perm32(int rho) { const int n = rho >> 4, i = rho & 15; return 8 * (i >> 2) + 4 * n + (i & 3); }

struct Unit { int pm, pn; };
struct Gemm { const bf16_t* A; const bf16_t* Bt; int lda; int Mr, N, K; };

struct StaticOrder {
    int nM, nN, nwg, G, c;
    __host__ __device__ void init(int Mr, int N, int G_, int c_) { nM = Mr / BM; nN = N / BM; nwg = nM * nN; G = G_; c = c_; }
    __host__ __device__ bool next(int i, Unit& u) const {
        const long L = (long)i * G + c; if (L >= nwg) return false;
        int wgid = (int)L; { const int q = nwg / NXCD, r = nwg % NXCD, xcd = wgid % NXCD, off = wgid / NXCD; wgid = (xcd < r ? xcd * (q + 1) : r * (q + 1) + (xcd - r) * q) + off; }
        const int nig = WGM * nN, gid = wgid / nig, fm = gid * WGM, gsz = (nM - fm) < WGM ? (nM - fm) : WGM;
        u.pm = fm + ((wgid % nig) % gsz); u.pn = (wgid % nig) / gsz; return true;
    }
};

__device__ __forceinline__ unsigned cvt_pk_bf16(float lo, float hi) { unsigned r; asm volatile("v_cvt_pk_bf16_f32 %0, %1, %2" : "=v"(r) : "v"(lo), "v"(hi)); return r; }
__device__ __forceinline__ float bf_lo(unsigned w) { return __uint_as_float(w << 16); }
__device__ __forceinline__ float bf_hi(unsigned w) { return __uint_as_float(w & 0xffff0000u); }
__device__ __forceinline__ float sigm(float v) { return __builtin_amdgcn_rcpf(1.f + __builtin_amdgcn_exp2f(-1.4426950408889634f * v)); }

struct EpiInProj {
    static constexpr bool PERM = true, MID = false;
    bf16_t* O; int ldc; const float* bg;
    __device__ __forceinline__ void operator()(const f32x4 (&acc)[2][2][4][2], const Unit& u, int wr, int wc, int fr, int fq) const {
        const int row0 = u.pm * BM + wr * 64 + fr, col0 = u.pn * BM + wc * 32 + 8 * fq;
        const bool isg = (u.pn >= 10 && u.pn < 26);
        f32x4 bv[2][2];
#pragma unroll
        for (int bj = 0; bj < 2; ++bj)
#pragma unroll
            for (int n = 0; n < 2; ++n) bv[bj][n] = isg ? *(const f32x4*)(bg + (col0 - PC_GATE) + bj * HALF + 4 * n) : (f32x4){0.f, 0.f, 0.f, 0.f};
#pragma unroll
        for (int ai = 0; ai < 2; ++ai)
#pragma unroll
            for (int m = 0; m < 4; ++m) { bf16_t* rowp = O + (size_t)(row0 + ai * HALF + m * 16) * ldc + col0;
#pragma unroll
                for (int bj = 0; bj < 2; ++bj) { f32x4 v0 = acc[ai][bj][m][0] + bv[bj][0], v1 = acc[ai][bj][m][1] + bv[bj][1];
                    if (isg) {
#pragma unroll
                        for (int j = 0; j < 4; ++j) { v0[j] = sigm(v0[j]); v1[j] = sigm(v1[j]); } }
                    u32x4 w; w.x = cvt_pk_bf16(v0[0], v0[1]); w.y = cvt_pk_bf16(v0[2], v0[3]); w.z = cvt_pk_bf16(v1[0], v1[1]); w.w = cvt_pk_bf16(v1[2], v1[3]);
                    *(u32x4*)(rowp + bj * HALF) = w; } }
    }
};
struct EpiRowScale {
    static constexpr bool PERM = true, MID = false;
    bf16_t* O; int ldc; const float* rs; float mul;
    __device__ __forceinline__ void operator()(const f32x4 (&acc)[2][2][4][2], const Unit& u, int wr, int wc, int fr, int fq) const {
        const int row0 = u.pm * BM + wr * 64 + fr, col0 = u.pn * BM + wc * 32 + 8 * fq;
#pragma unroll
        for (int ai = 0; ai < 2; ++ai)
#pragma unroll
            for (int m = 0; m < 4; ++m) { const int row = row0 + ai * HALF + m * 16; const float sc = (rs ? rs[row] : 1.f) * mul; bf16_t* rowp = O + (size_t)row * ldc + col0;
#pragma unroll
                for (int bj = 0; bj < 2; ++bj) { f32x4 v0 = acc[ai][bj][m][0] * sc, v1 = acc[ai][bj][m][1] * sc;
                    u32x4 w; w.x = cvt_pk_bf16(v0[0], v0[1]); w.y = cvt_pk_bf16(v0[2], v0[3]); w.z = cvt_pk_bf16(v1[0], v1[1]); w.w = cvt_pk_bf16(v1[2], v1[3]);
                    *(u32x4*)(rowp + bj * HALF) = w; } }
    }
};
struct EpiQM {
    static constexpr bool PERM = true, MID = false;
    bf16_t* O; int ldc; const float* rs; float mul; const float* CM; const float* SM; unsigned* nrm;
    __device__ __forceinline__ void operator()(const f32x4 (&acc)[2][2][4][2], const Unit& u, int wr, int wc, int fr, int fq) const {
        const int row0 = u.pm * BM + wr * 64 + fr, col0 = u.pn * BM + wc * 32 + 8 * fq;
        int ropef[2];
#pragma unroll
        for (int bj = 0; bj < 2; ++bj) { const int c0 = col0 + bj * HALF, within = c0 % 192; ropef[bj] = (within >= 128) ? ((within - 128) >> 1) : -1; }
        float pmx = 0.f;
#pragma unroll
        for (int ai = 0; ai < 2; ++ai)
#pragma unroll
            for (int m = 0; m < 4; ++m) { const int row = row0 + ai * HALF + m * 16; const float sc = rs[row] * mul; bf16_t* rowp = O + (size_t)row * ldc + col0;
                const int tp = row & 8191, prow = tp >> 6, pcol = tp & 63;
#pragma unroll
                for (int bj = 0; bj < 2; ++bj) { f32x4 v0 = acc[ai][bj][m][0] * sc, v1 = acc[ai][bj][m][1] * sc;
                    if (ropef[bj] >= 0) { const int i0 = ropef[bj], pos = (i0 < 16) ? prow : pcol, f0 = i0 & 15;
                        const f32x4 cs = *(const f32x4*)(CM + pos * 16 + f0), sn = *(const f32x4*)(SM + pos * 16 + f0);
                        const f32x4 a0 = v0, a1 = v1;
                        v0[0] = a0[0] * cs[0] - a0[1] * sn[0]; v0[1] = a0[0] * sn[0] + a0[1] * cs[0]; v0[2] = a0[2] * cs[1] - a0[3] * sn[1]; v0[3] = a0[2] * sn[1] + a0[3] * cs[1];
                        v1[0] = a1[0] * cs[2] - a1[1] * sn[2]; v1[1] = a1[0] * sn[2] + a1[1] * cs[2]; v1[2] = a1[2] * cs[3] - a1[3] * sn[3]; v1[3] = a1[2] * sn[3] + a1[3] * cs[3]; }
                    float q = (v0[0] * v0[0] + v0[1] * v0[1]) + (v0[2] * v0[2] + v0[3] * v0[3]) + (v1[0] * v1[0] + v1[1] * v1[1]) + (v1[2] * v1[2] + v1[3] * v1[3]);
                    q += __shfl_xor(q, 16); q += __shfl_xor(q, 32); pmx = fmaxf(pmx, q);
                    u32x4 w; w.x = cvt_pk_bf16(v0[0], v0[1]); w.y = cvt_pk_bf16(v0[2], v0[3]); w.z = cvt_pk_bf16(v1[0], v1[1]); w.w = cvt_pk_bf16(v1[2], v1[3]);
                    *(u32x4*)(rowp + bj * HALF) = w; } }
#pragma unroll
        for (int o = 1; o < 16; o <<= 1) pmx = fmaxf(pmx, __shfl_xor(pmx, o));
        if ((fr | fq) == 0) atomicMax(nrm, __float_as_uint(pmx * 1.02f));
    }
};
struct EpiKVNorm {
    static constexpr bool PERM = true, MID = false;
    bf16_t* O; int ldc; const float* rs; unsigned* nrm;
    __device__ __forceinline__ void operator()(const f32x4 (&acc)[2][2][4][2], const Unit& u, int wr, int wc, int fr, int fq) const {
        const int row0 = u.pm * BM + wr * 64 + fr, col0 = u.pn * BM + wc * 32 + 8 * fq;
        float pmx = 0.f;
#pragma unroll
        for (int ai = 0; ai < 2; ++ai)
#pragma unroll
            for (int m = 0; m < 4; ++m) { const int row = row0 + ai * HALF + m * 16; const float sc = rs[row]; bf16_t* rowp = O + (size_t)row * ldc + col0;
#pragma unroll
                for (int bj = 0; bj < 2; ++bj) { f32x4 v0 = acc[ai][bj][m][0] * sc, v1 = acc[ai][bj][m][1] * sc;
                    if (bj == 0) { float q = (v0[0] * v0[0] + v0[1] * v0[1]) + (v0[2] * v0[2] + v0[3] * v0[3]) + (v1[0] * v1[0] + v1[1] * v1[1]) + (v1[2] * v1[2] + v1[3] * v1[3]);
                        q += __shfl_xor(q, 16); q += __shfl_xor(q, 32); pmx = fmaxf(pmx, q); }
                    u32x4 w; w.x = cvt_pk_bf16(v0[0], v0[1]); w.y = cvt_pk_bf16(v0[2], v0[3]); w.z = cvt_pk_bf16(v1[0], v1[1]); w.w = cvt_pk_bf16(v1[2], v1[3]);
                    *(u32x4*)(rowp + bj * HALF) = w; } }
#pragma unroll
        for (int o = 1; o < 16; o <<= 1) pmx = fmaxf(pmx, __shfl_xor(pmx, o));
        if ((fr | fq) == 0) atomicMax(nrm, __float_as_uint(pmx * 1.02f));
    }
};
template <bool ADD> struct EpiGate {
    static constexpr bool PERM = true, MID = false;
    bf16_t* O; int ldc; const bf16_t* Gt; int ldg; const bf16_t* T; int ldt;
    __device__ __forceinline__ void operator()(const f32x4 (&acc)[2][2][4][2], const Unit& u, int wr, int wc, int fr, int fq) const {
        const int row0 = u.pm * BM + wr * 64 + fr, col0 = u.pn * BM + wc * 32 + 8 * fq;
#pragma unroll
        for (int ai = 0; ai < 2; ++ai)
#pragma unroll
            for (int m = 0; m < 4; ++m) { const int row = row0 + ai * HALF + m * 16; bf16_t* rowp = O + (size_t)row * ldc + col0;
#pragma unroll
                for (int bj = 0; bj < 2; ++bj) {
                    const u32x4 g = *(const u32x4*)(Gt + (size_t)row * ldg + col0 + bj * HALF);
                    f32x4 v0 = acc[ai][bj][m][0], v1 = acc[ai][bj][m][1];
                    v0[0] *= bf_lo(g.x); v0[1] *= bf_hi(g.x); v0[2] *= bf_lo(g.y); v0[3] *= bf_hi(g.y);
                    v1[0] *= bf_lo(g.z); v1[1] *= bf_hi(g.z); v1[2] *= bf_lo(g.w); v1[3] *= bf_hi(g.w);
                    if (ADD) { const u32x4 t = *(const u32x4*)(T + (size_t)row * ldt + col0 + bj * HALF);
                        v0[0] += bf_lo(t.x); v0[1] += bf_hi(t.x); v0[2] += bf_lo(t.y); v0[3] += bf_hi(t.y);
                        v1[0] += bf_lo(t.z); v1[1] += bf_hi(t.z); v1[2] += bf_lo(t.w); v1[3] += bf_hi(t.w); }
                    u32x4 w; w.x = cvt_pk_bf16(v0[0], v0[1]); w.y = cvt_pk_bf16(v0[2], v0[3]); w.z = cvt_pk_bf16(v1[0], v1[1]); w.w = cvt_pk_bf16(v1[2], v1[3]);
                    *(u32x4*)(rowp + bj * HALF) = w; } }
    }
};
struct EpiGateMerge {
    static constexpr bool PERM = true, MID = true;
    bf16_t* O; int ldc; const bf16_t* G1; const bf16_t* G2; int ldg;
    __device__ __forceinline__ void mid(f32x4 (&acc)[2][2][4][2], const Unit& u, int wr, int wc, int fr, int fq) const {
        int row0 = u.pm * BM + wr * 64 + fr, col0 = u.pn * BM + wc * 32 + 8 * fq;
        asm volatile("" : "+v"(row0), "+v"(col0));
#pragma unroll
        for (int ai = 0; ai < 2; ++ai)
#pragma unroll
            for (int m = 0; m < 4; ++m) { const size_t ro = (size_t)(row0 + ai * HALF + m * 16) * ldg + col0;
#pragma unroll
                for (int bj = 0; bj < 2; ++bj) {
                    const u32x4 a = *(const u32x4*)(G1 + ro + bj * HALF), b = *(const u32x4*)(G2 + ro + bj * HALF);
                    f32x4& v0 = acc[ai][bj][m][0]; f32x4& v1 = acc[ai][bj][m][1];
#define PG8_RT(x, y) ((x) * __builtin_amdgcn_rcpf(fmaxf((y), 1e-6f)))
                    v0[0] *= PG8_RT(bf_lo(a.x), bf_lo(b.x)); v0[1] *= PG8_RT(bf_hi(a.x), bf_hi(b.x)); v0[2] *= PG8_RT(bf_lo(a.y), bf_lo(b.y)); v0[3] *= PG8_RT(bf_hi(a.y), bf_hi(b.y));
                    v1[0] *= PG8_RT(bf_lo(a.z), bf_lo(b.z)); v1[1] *= PG8_RT(bf_hi(a.z), bf_hi(b.z)); v1[2] *= PG8_RT(bf_lo(a.w), bf_lo(b.w)); v1[3] *= PG8_RT(bf_hi(a.w), bf_hi(b.w));
#undef PG8_RT
                }
                asm volatile("" ::: "memory"); }
    }
    __device__ __forceinline__ void operator()(const f32x4 (&acc)[2][2][4][2], const Unit& u, int wr, int wc, int fr, int fq) const {
        const int row0 = u.pm * BM + wr * 64 + fr, col0 = u.pn * BM + wc * 32 + 8 * fq;
#pragma unroll
        for (int ai = 0; ai < 2; ++ai)
#pragma unroll
            for (int m = 0; m < 4; ++m) { const int row = row0 + ai * HALF + m * 16; bf16_t* rowp = O + (size_t)row * ldc + col0;
#pragma unroll
                for (int bj = 0; bj < 2; ++bj) {
                    const u32x4 g = *(const u32x4*)(G2 + (size_t)row * ldg + col0 + bj * HALF);
                    f32x4 v0 = acc[ai][bj][m][0], v1 = acc[ai][bj][m][1];
                    v0[0] *= fmaxf(bf_lo(g.x), 1e-6f); v0[1] *= fmaxf(bf_hi(g.x), 1e-6f); v0[2] *= fmaxf(bf_lo(g.y), 1e-6f); v0[3] *= fmaxf(bf_hi(g.y), 1e-6f);
                    v1[0] *= fmaxf(bf_lo(g.z), 1e-6f); v1[1] *= fmaxf(bf_hi(g.z), 1e-6f); v1[2] *= fmaxf(bf_lo(g.w), 1e-6f); v1[3] *= fmaxf(bf_hi(g.w), 1e-6f);
                    u32x4 w; w.x = cvt_pk_bf16(v0[0], v0[1]); w.y = cvt_pk_bf16(v0[2], v0[3]); w.z = cvt_pk_bf16(v1[0], v1[1]); w.w = cvt_pk_bf16(v1[2], v1[3]);
                    *(u32x4*)(rowp + bj * HALF) = w; } }
    }
};
struct EpiResid {
    static constexpr bool PERM = false, MID = false;
    const float* base; float* out; const float* gm; int gstride;
    __device__ __forceinline__ void operator()(const f32x4 (&acc)[2][2][4][2], const Unit& u, int wr, int wc, int fr, int fq) const {
        const int col0 = u.pn * BM + wc * 32 + 4 * fq; const float* gp = gm + (size_t)(u.pm >> 5) * gstride + col0;
        f32x4 gv[2][2];
#pragma unroll
        for (int bj = 0; bj < 2; ++bj)
#pragma unroll
            for (int n = 0; n < 2; ++n) gv[bj][n] = *(const f32x4*)(gp + bj * HALF + n * 16);
#pragma unroll
        for (int ai = 0; ai < 2; ++ai)
#pragma unroll
            for (int m = 0; m < 4; ++m) { const size_t off = (size_t)(u.pm * BM + ai * HALF + wr * 64 + m * 16 + fr) * DM + col0;
#pragma unroll
                for (int bj = 0; bj < 2; ++bj)
#pragma unroll
                    for (int n = 0; n < 2; ++n) { const f32x4 bs = *(const f32x4*)(base + off + bj * HALF + n * 16);
                        *(f32x4*)(out + off + bj * HALF + n * 16) = bs * ALPHA + gv[bj][n] * acc[ai][bj][m][n]; } }
    }
};
struct EpiSwiGLU {
    static constexpr bool PERM = true, MID = false;
    bf16_t* O; int ldc;
    __device__ __forceinline__ void operator()(const f32x4 (&acc)[2][2][4][2], const Unit& u, int wr, int wc, int fr, int fq) const {
        const int row0 = u.pm * BM + wr * 64 + fr, col0 = u.pn * HALF + wc * 32 + 8 * fq;
#pragma unroll
        for (int ai = 0; ai < 2; ++ai)
#pragma unroll
            for (int m = 0; m < 4; ++m) { bf16_t* rowp = O + (size_t)(row0 + ai * HALF + m * 16) * ldc + col0;
                f32x4 v0, v1;
#pragma unroll
                for (int j = 0; j < 4; ++j) { const float g0 = acc[ai][0][m][0][j], g1 = acc[ai][0][m][1][j];
                    v0[j] = g0 * sigm(g0) * acc[ai][1][m][0][j]; v1[j] = g1 * sigm(g1) * acc[ai][1][m][1][j]; }
                u32x4 w; w.x = cvt_pk_bf16(v0[0], v0[1]); w.y = cvt_pk_bf16(v0[2], v0[3]); w.z = cvt_pk_bf16(v1[0], v1[1]); w.w = cvt_pk_bf16(v1[2], v1[3]);
                *(u32x4*)rowp = w; }
    }
};

template <class Epi>
__device__ __forceinline__ void gemm_phase(PG8_LAS unsigned char* lds, const Gemm g, const StaticOrder& S, const Epi& E, int wv) {
    int tid = wv * 64 + mk_lane_id(); asm volatile("" : "+v"(tid));
    const int wid = __builtin_amdgcn_readfirstlane(tid >> 6), lane = tid & 63, wr = wid >> 2, wc = wid & 3, fr = lane & 15, fq = lane >> 4;
    const int K = g.K, nt = K / BK, lda = g.lda;
    unsigned voffA[2], voffB[2];
#pragma unroll
    for (int i = 0; i < 2; ++i) { int R, C; stage_rc(tid * 16 + i * 8192, R, C); const int Rb = Epi::PERM ? ((R & ~31) + perm32(R & 31)) : R;
        voffA[i] = (unsigned)(R * lda + C) * 2u; voffB[i] = (unsigned)(Rb * K + C) * 2u; }
    const size_t kstep = (size_t)(BK * 2);
    const size_t hstepA = (size_t)HALF * lda * 2, hstepB = (size_t)HALF * K * 2;
    const size_t tstepA = 2 * hstepA, tstepB = 2 * hstepB;
    const unsigned ldsw = (unsigned)wid * 1024u;
    const int aoff = lds_byte(wr * 64 + fr, fq * 8), boff = lds_byte(wc * 32 + fr, fq * 8);
#define PG8_SA(b, h) (((b) * 2 + (h)) * HTB)
#define PG8_SB(b, h) ((4 + (b) * 2 + (h)) * HTB)
#define PG8_STAGE(bufoff, gbase, voff) do { _Pragma("unroll") for (int _i = 0; _i < 2; ++_i) \
        __builtin_amdgcn_global_load_lds((const unsigned*)((const char*)(gbase) + (voff)[_i]), (PG8_LAS unsigned*)(lds + (bufoff) + ldsw + _i * 8192), 16, 0, 0); } while (0)
#define PG8_LDA(dst, b, h) do { _Pragma("unroll") for (int m = 0; m < 4; ++m) _Pragma("unroll") for (int k = 0; k < 2; ++k) dst[m][k] = *(const PG8_LAS bf16x8*)(lds + PG8_SA(b, h) + aoff + m * 2048 + k * 1024); } while (0)
#define PG8_LDB(dst, b, h) do { _Pragma("unroll") for (int n = 0; n < 2; ++n) _Pragma("unroll") for (int k = 0; k < 2; ++k) dst[n][k] = *(const PG8_LAS bf16x8*)(lds + PG8_SB(b, h) + boff + n * 2048 + k * 1024); } while (0)
#define PG8_MMA(ai, bj, At, Bt) do { __builtin_amdgcn_s_setprio(1); _Pragma("unroll") for (int m = 0; m < 4; ++m) _Pragma("unroll") for (int n = 0; n < 2; ++n) _Pragma("unroll") for (int k = 0; k < 2; ++k) \
        acc[ai][bj][m][n] = __builtin_amdgcn_mfma_f32_16x16x32_bf16(Bt[n][k], At[m][k], acc[ai][bj][m][n], 0, 0, 0); __builtin_amdgcn_s_setprio(0); } while (0)
#define PG8_WAIT_V(n) asm volatile("s_waitcnt vmcnt(" #n ")" ::: "memory")
#define PG8_WAIT_L(n) asm volatile("s_waitcnt lgkmcnt(" #n ")" ::: "memory")
#define PG8_BAR __builtin_amdgcn_s_barrier()
#define PG8_SCHED __builtin_amdgcn_sched_barrier(0)
    Unit cur, nxt; int ui = 0;
    if (!S.next(0, cur)) return;
    f32x4 acc[2][2][4][2];
#pragma unroll
    for (int a = 0; a < 2; ++a)
#pragma unroll
        for (int b = 0; b < 2; ++b)
#pragma unroll
            for (int m = 0; m < 4; ++m)
#pragma unroll
                for (int n = 0; n < 2; ++n) acc[a][b][m][n] = (f32x4){0.f, 0.f, 0.f, 0.f};
    bf16x8 At[4][2], B0[2][2], B1[2][2];
    const char* cA = (const char*)g.A + (size_t)cur.pm * tstepA; const char* cB = (const char*)g.Bt + (size_t)cur.pn * tstepB;
    PG8_STAGE(PG8_SB(0, 0), cB, voffB); PG8_STAGE(PG8_SB(0, 1), cB + hstepB, voffB); PG8_STAGE(PG8_SA(0, 0), cA, voffA); PG8_STAGE(PG8_SA(0, 1), cA + hstepA, voffA);
    if (wr == 1) PG8_BAR;
    PG8_WAIT_V(2); PG8_BAR;
    PG8_STAGE(PG8_SB(1, 0), cB + kstep, voffB); PG8_STAGE(PG8_SA(1, 0), cA + kstep, voffA); PG8_STAGE(PG8_SB(1, 1), cB + hstepB + kstep, voffB);
    PG8_WAIT_V(6); PG8_BAR;
    for (;;) {
        const bool has_next = S.next(ui + 1, nxt);
        const char* nA = has_next ? (const char*)g.A + (size_t)nxt.pm * tstepA : cA; const char* nB = has_next ? (const char*)g.Bt + (size_t)nxt.pn * tstepB : cB;
        for (int t = 0; t < nt; t += 2) {
            if constexpr (Epi::MID) { if (t == (nt >> 1)) E.mid(acc, cur, wr, wc, fr, fq); }
            const bool last = (t == nt - 2);
            const char* a1 = cA + (size_t)(t + 1) * kstep;
            const char* a2 = last ? nA : cA + (size_t)(t + 2) * kstep; const char* b2 = last ? nB : cB + (size_t)(t + 2) * kstep;
            const char* a3 = a2 + kstep; const char* b3 = b2 + kstep;
            PG8_LDB(B0, 0, 0); PG8_LDB(B1, 0, 1); PG8_SCHED; PG8_LDA(At, 0, 0); PG8_STAGE(PG8_SA(1, 1), a1 + hstepA, voffA);
            PG8_WAIT_V(8); PG8_WAIT_L(0); PG8_BAR; PG8_MMA(0, 0, At, B0); PG8_MMA(0, 1, At, B1); PG8_BAR; PG8_SCHED;
            PG8_LDA(At, 0, 1); PG8_STAGE(PG8_SB(0, 0), b2, voffB); PG8_STAGE(PG8_SB(0, 1), b2 + hstepB, voffB); PG8_STAGE(PG8_SA(0, 0), a2, voffA);
            PG8_WAIT_V(8); PG8_WAIT_L(0); PG8_BAR; PG8_MMA(1, 0, At, B0); PG8_MMA(1, 1, At, B1); PG8_BAR; PG8_SCHED;
            PG8_LDB(B0, 1, 0); PG8_LDB(B1, 1, 1); PG8_SCHED; PG8_LDA(At, 1, 0); PG8_STAGE(PG8_SA(0, 1), a2 + hstepA, voffA);
            PG8_WAIT_V(8); PG8_WAIT_L(0); PG8_BAR; PG8_MMA(0, 0, At, B0); PG8_MMA(0, 1, At, B1); PG8_BAR; PG8_SCHED;
            PG8_LDA(At, 1, 1); PG8_STAGE(PG8_SB(1, 0), b3, voffB); PG8_STAGE(PG8_SB(1, 1), b3 + hstepB, voffB); PG8_STAGE(PG8_SA(1, 0), a3, voffA);
            PG8_WAIT_V(8); PG8_WAIT_L(0); PG8_BAR; PG8_MMA(1, 0, At, B0); PG8_MMA(1, 1, At, B1); PG8_BAR; PG8_SCHED;
        }
        if (wr == 0) PG8_BAR;
        E(acc, cur, wr, wc, fr, fq);
        if (!has_next) break;
#pragma unroll
        for (int a = 0; a < 2; ++a)
#pragma unroll
            for (int b = 0; b < 2; ++b)
#pragma unroll
                for (int m = 0; m < 4; ++m)
#pragma unroll
                    for (int n = 0; n < 2; ++n) acc[a][b][m][n] = (f32x4){0.f, 0.f, 0.f, 0.f};
        cur = nxt; cA = nA; cB = nB; ++ui;
        if (wr == 1) PG8_BAR;
    }
    PG8_WAIT_V(0);
    PG8_BAR;
#undef PG8_SA
#undef PG8_SB
#undef PG8_STAGE
#undef PG8_LDA
#undef PG8_LDB
#undef PG8_MMA
#undef PG8_WAIT_V
#undef PG8_WAIT_L
#undef PG8_BAR
#undef PG8_SCHED
}
}

namespace att {
using bf16 = unsigned short;
using bf16x8 = __attribute__((ext_vector_type(8))) short;
using s16x4  = __attribute__((ext_vector_type(4))) short;
using f32x16 = __attribute__((ext_vector_type(16))) float;
using u32x4  = __attribute__((ext_vector_type(4))) unsigned;
using f32x4  = __attribute__((ext_vector_type(4))) float;
constexpr int DV = 128, NW = 8, QBLK = 32, KVBLK = 64;
constexpr float THR = 8.f;
#define SBAR() __builtin_amdgcn_sched_barrier(0)
__device__ __forceinline__ int crow(int r, int hi) { return (r & 3) + 8 * (r >> 2) + 4 * hi; }
__device__ __forceinline__ unsigned cvtpk(float lo, float hi) { unsigned r; asm volatile("v_cvt_pk_bf16_f32 %0, %1, %2" : "=v"(r) : "v"(lo), "v"(hi)); return r; }

template <int DQK> struct Cfg {
    static constexpr int KROWB = DQK * 2;
    static constexpr int SHM_K = KVBLK * KROWB, SHM_V = KVBLK * DV * 2;
    static constexpr int SHM_TOTAL = 2 * SHM_V + 2 * SHM_K + NW * 64 * 4;
    static constexpr float SCALE = (DQK == 128) ? 0.088388347648318440f : 0.072168783648703220f;
    static constexpr float C = SCALE * 1.4426950408889634f;
};
template <int DQK> __device__ __forceinline__ int kswz(int row, int colB) {
  if (DQK == 128 || colB < 256) return row * Cfg<DQK>::KROWB + (colB ^ ((row & 15) << 4));
  return row * Cfg<DQK>::KROWB + 256 + ((colB - 256) ^ (((row >> 1) & 7) << 4));
}

template <int DQK> __device__ __forceinline__ void partialSM(f32x16& p0, f32x16& p1, float& m_reg, float& mn, float& alpha) {
  constexpr float THR2 = THR * 1.4426950408889634f;
  float pmax = p0[0];
#pragma unroll
  for (int r = 1; r < 16; ++r) pmax = fmaxf(pmax, p0[r]);
#pragma unroll
  for (int r = 0; r < 16; ++r) pmax = fmaxf(pmax, p1[r]);
  { auto rr = __builtin_amdgcn_permlane32_swap(__float_as_uint(pmax), __float_as_uint(pmax), false, false);
    pmax = fmaxf(__uint_as_float(rr[0]), __uint_as_float(rr[1])); }
  if (__builtin_expect(__all(pmax - m_reg <= THR2), 1)) { mn = m_reg; alpha = 1.f; }
  else { mn = fmaxf(m_reg, pmax); alpha = __builtin_amdgcn_exp2f(m_reg - mn); m_reg = mn; }
#pragma unroll
  for (int r = 0; r < 16; ++r) p0[r] = p0[r] - mn;
#pragma unroll
  for (int r = 0; r < 16; ++r) p1[r] = p1[r] - mn;
#pragma unroll
  for (int r = 0; r < 16; ++r) p0[r] = __builtin_amdgcn_exp2f(p0[r]);
}
__device__ __forceinline__ void partialSM_fast(f32x16& p0) {
#pragma unroll
  for (int r = 0; r < 16; ++r) p0[r] = __builtin_amdgcn_exp2f(p0[r]);
}
__device__ __forceinline__ void finishSM(f32x16& p0, f32x16& p1, float alpha, float& l_reg, bf16x8& pa0, bf16x8& pa1, bf16x8& pa2, bf16x8& pa3) {
#pragma unroll
  for (int r = 0; r < 16; ++r) p1[r] = __builtin_amdgcn_exp2f(p1[r]);
  float ps = 0;
#pragma unroll
  for (int r = 0; r < 16; ++r) ps += p0[r];
#pragma unroll
  for (int r = 0; r < 16; ++r) ps += p1[r];
  { auto rr = __builtin_amdgcn_permlane32_swap(__float_as_uint(ps), __float_as_uint(ps), false, false);
    ps = __uint_as_float(rr[0]) + __uint_as_float(rr[1]); }
  l_reg = l_reg * alpha + ps;
#define PK4(P, BASE, OUT) do { unsigned a0 = cvtpk(P[BASE + 0], P[BASE + 1]), a1 = cvtpk(P[BASE + 2], P[BASE + 3]);   \
    unsigned b0 = cvtpk(P[BASE + 4], P[BASE + 5]), b1 = cvtpk(P[BASE + 6], P[BASE + 7]);                              \
    auto r0 = __builtin_amdgcn_permlane32_swap(a0, b0, false, false); auto r1 = __builtin_amdgcn_permlane32_swap(a1, b1, false, false); \
    u32x4 w = {r0[0], r1[0], r0[1], r1[1]}; OUT = *reinterpret_cast<bf16x8*>(&w); } while (0)
  PK4(p0, 0, pa0); PK4(p0, 8, pa1); PK4(p1, 0, pa2); PK4(p1, 8, pa3);
#undef PK4
}
template <int DQK, int QREG> __device__ __forceinline__ void qkt(f32x16& p0, f32x16& p1, const char* Ks, const bf16x8* qr, const char* ql, int r32, int hi) {
  p0 = f32x16{}; p1 = f32x16{};
  unsigned ql2 = (unsigned)(uintptr_t)ql; if (QREG < DQK / 16) asm volatile("" : "+v"(ql2));
  asm volatile("" : "+v"(r32));
#pragma unroll
  for (int d0 = 0; d0 < DQK / 16; ++d0) { int cb = (d0 * 16 + hi * 8) * 2;
    bf16x8 b0 = *reinterpret_cast<const bf16x8*>(Ks + kswz<DQK>(r32, cb));
    bf16x8 b1 = *reinterpret_cast<const bf16x8*>(Ks + kswz<DQK>(32 + r32, cb));
    bf16x8 q; if (d0 < QREG) q = qr[d0]; else q = *(const __attribute__((address_space(3))) bf16x8*)(ql2 + (d0 - QREG) * 32);
    p0 = __builtin_amdgcn_mfma_f32_32x32x16_bf16(b0, q, p0, 0, 0, 0);
    p1 = __builtin_amdgcn_mfma_f32_32x32x16_bf16(b1, q, p1, 0, 0, 0); }
}
__device__ __forceinline__ int v_st(int k, int c) { const int kk = (k & ~0xC) | ((k & 4) << 1) | ((k & 8) >> 1); return ((kk >> 3) * 4 + (c >> 5)) * 512 + ((kk & 7) * 32 + (c & 31)) * 2; }
__device__ __forceinline__ int v_rd_base(int lane) { return ((lane & 3) << 3) | (((lane >> 2) & 3) << 6) | (((lane >> 4) & 1) << 5) | (((lane >> 5) & 1) << 8); }
constexpr int v_rd_off(int d0, int ks, int half) { return d0 * 512 + ks * 4096 + half * 2048; }
template <int OFF> __device__ __forceinline__ s16x4 tr_read(int vb) {
  s16x4 r; asm volatile("ds_read_b64_tr_b16 %0, %1 offset:%2" : "=&v"(r) : "v"(vb), "i"(OFF) : "memory"); return r;
}
template <int D0> __device__ __forceinline__ void pv_one(f32x16& od, int vb, bf16x8 pa0, bf16x8 pa1, bf16x8 pa2, bf16x8 pa3) {
  const s16x4 l0 = tr_read<v_rd_off(D0, 0, 0)>(vb), h0 = tr_read<v_rd_off(D0, 0, 1)>(vb), l1 = tr_read<v_rd_off(D0, 1, 0)>(vb), h1 = tr_read<v_rd_off(D0, 1, 1)>(vb);
  const s16x4 l2 = tr_read<v_rd_off(D0, 2, 0)>(vb), h2 = tr_read<v_rd_off(D0, 2, 1)>(vb), l3 = tr_read<v_rd_off(D0, 3, 0)>(vb), h3 = tr_read<v_rd_off(D0, 3, 1)>(vb);
  asm volatile("s_waitcnt lgkmcnt(0)" ::: "memory"); SBAR();
#define PK(L, H) (bf16x8){L[0], L[1], L[2], L[3], H[0], H[1], H[2], H[3]}
  od = __builtin_amdgcn_mfma_f32_32x32x16_bf16(pa0, PK(l0, h0), od, 0, 0, 0);
  od = __builtin_amdgcn_mfma_f32_32x32x16_bf16(pa1, PK(l1, h1), od, 0, 0, 0);
  od = __builtin_amdgcn_mfma_f32_32x32x16_bf16(pa2, PK(l2, h2), od, 0, 0, 0);
  od = __builtin_amdgcn_mfma_f32_32x32x16_bf16(pa3, PK(l3, h3), od, 0, 0, 0);
#undef PK
}
__device__ __forceinline__ void pv_d0(f32x16* o, int vb, bf16x8 pa0, bf16x8 pa1, bf16x8 pa2, bf16x8 pa3) {
  pv_one<0>(o[0], vb, pa0, pa1, pa2, pa3); pv_one<1>(o[1], vb, pa0, pa1, pa2, pa3); pv_one<2>(o[2], vb, pa0, pa1, pa2, pa3); pv_one<3>(o[3], vb, pa0, pa1, pa2, pa3);
}

template <int DQK, int QREG, int SDEPTH, int LDQ, int LDK, int LDKR, int LDV, int LDO>
__device__ __forceinline__ void attn_unit(const bf16* __restrict__ Qb, const bf16* __restrict__ Kh, const bf16* __restrict__ Kr, const bf16* __restrict__ Vh,
                                          bf16* __restrict__ Ob, int seq, char* lds, int wv) {
  using CF = Cfg<DQK>;
  constexpr int SHM_V = CF::SHM_V, SHM_K = CF::SHM_K; constexpr bool ROPE = (DQK == 192);
  int tid = wv * 64 + mk_lane_id(); asm volatile("" : "+v"(tid));
  const int wid = tid >> 6, lane = tid & 63, r32 = lane & 31, hi = lane >> 5;
  char* V_lds = lds; char* K_lds = lds + 2 * SHM_V;
  float* ws = (float*)(lds + 2 * SHM_V + 2 * SHM_K) + wid * 64; float* li_l = ws; float* al_l = ws + 32;
  float m_reg = -1e30f, l_reg = 0; f32x16 o[4] = {}; bf16x8 qr[QREG];
  constexpr int QL = DQK / 16 - QREG, QSTR = QL * 32 + 16;
  char* ql = lds + 2 * SHM_V + 2 * SHM_K + NW * 64 * 4 + (wid * QBLK + r32) * QSTR + hi * 16;
  const bf16* Qw = Qb + (long)(wid * QBLK + r32) * LDQ + hi * 8;
#pragma unroll
  for (int d0 = 0; d0 < DQK / 16; ++d0) { const bf16x8 t = *reinterpret_cast<const bf16x8*>(Qw + d0 * 16); if (d0 < QREG) qr[d0] = t; else *reinterpret_cast<bf16x8*>(ql + (d0 - QREG) * 32) = t; }
  const int sr = tid >> 4, sc = (tid & 15) * 8, vst0 = v_st(sr, sc), vst1 = v_st(32 + sr, sc);
  const int rr_ = tid >> 3, rc_ = (tid & 7) * 8;
  const int vb0 = (int)(uintptr_t)V_lds + v_rd_base(lane);
  struct { bf16x8 vs0, vs1, ks0, ks1, kr; } sr_[SDEPTH];
#define SLOAD(i, k0) do { sr_[i].vs0 = *(const bf16x8*)(&Vh[(long)((k0) + sr) * LDV + sc]); sr_[i].vs1 = *(const bf16x8*)(&Vh[(long)((k0) + 32 + sr) * LDV + sc]); \
    sr_[i].ks0 = *(const bf16x8*)(&Kh[(long)((k0) + sr) * LDK + sc]); sr_[i].ks1 = *(const bf16x8*)(&Kh[(long)((k0) + 32 + sr) * LDK + sc]); \
    if constexpr (ROPE) sr_[i].kr = *(const bf16x8*)(&Kr[(long)((k0) + rr_) * LDKR + rc_]); } while (0)
#define SWRITE(b, i) do { *(bf16x8*)(V_lds + (b) * SHM_V + vst0) = sr_[i].vs0;          \
    *(bf16x8*)(V_lds + (b) * SHM_V + vst1) = sr_[i].vs1; int kc = sc * 2;               \
    *(bf16x8*)(K_lds + (b) * SHM_K + kswz<DQK>(sr, kc)) = sr_[i].ks0;                       \
    *(bf16x8*)(K_lds + (b) * SHM_K + kswz<DQK>(32 + sr, kc)) = sr_[i].ks1;                  \
    if constexpr (ROPE) *(bf16x8*)(K_lds + (b) * SHM_K + kswz<DQK>(rr_, 256 + rc_ * 2)) = sr_[i].kr; } while (0)
#define SWAIT() do { if constexpr (SDEPTH == 2) { if constexpr (ROPE) asm volatile("s_waitcnt vmcnt(5)" ::: "memory"); else asm volatile("s_waitcnt vmcnt(4)" ::: "memory"); } else asm volatile("s_waitcnt vmcnt(0)" ::: "memory"); } while (0)
#define RESC(a) do { if (__any((a) < 1.f)) { if (hi == 0) al_l[r32] = (a); asm volatile("s_waitcnt lgkmcnt(0)" ::: "memory"); \
    _Pragma("unroll") for (int d = 0; d < 4; ++d) _Pragma("unroll") for (int r = 0; r < 16; ++r) o[d][r] *= al_l[crow(r, hi)]; } } while (0)
  f32x16 pA0, pA1, pB0, pB1; float mnA, mnB, alA, alB; bf16x8 pa0, pa1, pa2, pa3; const int NT = seq / KVBLK;
  constexpr int SE = 0, SO = SDEPTH - 1;
  SLOAD(SE, 0); asm volatile("s_waitcnt vmcnt(0)" ::: "memory"); SWRITE(0, SE); __syncthreads();
  qkt<DQK, QREG>(pA0, pA1, K_lds, qr, ql, r32, hi); partialSM<DQK>(pA0, pA1, m_reg, mnA, alA);
  SLOAD(SO, KVBLK); if constexpr (SDEPTH == 2) { if (2 < NT) SLOAD(SE, 2 * KVBLK); }
  SWAIT(); SWRITE(1, SO); __syncthreads();
  for (int j = 1; j + 1 < NT; j += 2) {
    SBAR(); qkt<DQK, QREG>(pB0, pB1, K_lds + SHM_K, qr, ql, r32, hi);
    finishSM(pA0, pA1, alA, l_reg, pa0, pa1, pa2, pa3); SBAR();
    SLOAD(SO, (j + SDEPTH) * KVBLK); SBAR();
    pv_d0(o, vb0, pa0, pa1, pa2, pa3); partialSM<DQK>(pB0, pB1, m_reg, mnB, alB);
    __syncthreads(); SWAIT(); SWRITE(0, SE);
    RESC(alB); __syncthreads();
    SBAR(); qkt<DQK, QREG>(pA0, pA1, K_lds, qr, ql, r32, hi);
    finishSM(pB0, pB1, alB, l_reg, pa0, pa1, pa2, pa3); SBAR();
    if (SDEPTH == 1 || j + 3 < NT) SLOAD(SE, (j + 1 + SDEPTH) * KVBLK); SBAR();
    pv_d0(o, vb0 + (int)SHM_V, pa0, pa1, pa2, pa3); partialSM<DQK>(pA0, pA1, m_reg, mnA, alA);
    __syncthreads(); SWAIT(); SWRITE(1, SO);
    RESC(alA); __syncthreads();
  }
  SBAR(); qkt<DQK, QREG>(pB0, pB1, K_lds + SHM_K, qr, ql, r32, hi);
  finishSM(pA0, pA1, alA, l_reg, pa0, pa1, pa2, pa3); SBAR();
  pv_d0(o, vb0, pa0, pa1, pa2, pa3); partialSM<DQK>(pB0, pB1, m_reg, mnB, alB);
  __syncthreads(); RESC(alB);
  finishSM(pB0, pB1, alB, l_reg, pa0, pa1, pa2, pa3); SBAR();
  pv_d0(o, vb0 + (int)SHM_V, pa0, pa1, pa2, pa3);
  {
    int tid2 = wv * 64 + mk_lane_id(); asm volatile("" : "+v"(tid2));
    const int wid2 = tid2 >> 6, r32b = tid2 & 31, hib = (tid2 >> 5) & 1;
    float* li2 = (float*)(lds + 2 * SHM_V + 2 * SHM_K) + wid2 * 64;
    if (hib == 0) li2[r32b] = l_reg; asm volatile("s_waitcnt lgkmcnt(0)" ::: "memory");
    bf16* Ow = Ob + (long)(wid2 * QBLK) * LDO + r32b;
#pragma unroll
    for (int r = 0; r < 16; ++r) { const int orow = crow(r, hib); const float rl = __builtin_amdgcn_rcpf(li2[orow]);
#pragma unroll
      for (int d0 = 0; d0 < 4; ++d0) { const float v = o[d0][r] * rl; Ow[(long)orow * LDO + d0 * 32] = (bf16)(cvtpk(v, v) & 0xffffu); } }
  }
  __syncthreads();
#undef SLOAD
#undef SWRITE
#undef SWAIT
#undef RESC
}

template <int DQK, int QREG, int LDQ, int LDK, int LDKR, int LDV, int LDO>
__device__ __forceinline__ void attn_unit_dma(const bf16* __restrict__ Qb, const bf16* __restrict__ Kh, const bf16* __restrict__ Kr, const bf16* __restrict__ Vh,
                                              bf16* __restrict__ Ob, int seq, char* lds, __attribute__((address_space(3))) unsigned char* l3, const char* wsb) {
  using CF = Cfg<DQK>;
  constexpr int SHM_V = CF::SHM_V, SHM_K = CF::SHM_K; constexpr bool ROPE = (DQK == 192);
  constexpr int NKP = SHM_K / 8192;
  constexpr int OFF_K = 3 * SHM_V, OFF_WS = OFF_K + 3 * SHM_K, OFF_Q = OFF_WS + NW * 64 * 4;
  int tid = threadIdx.x; asm volatile("" : "+v"(tid));
  const int wid = tid >> 6, lane = tid & 63, r32 = lane & 31, hi = lane >> 5;
  const int wu = __builtin_amdgcn_readfirstlane(wid);
  char* V_lds = lds; char* K_lds = lds + OFF_K;
  float* ws = (float*)(lds + OFF_WS) + wid * 64; float* li_l = ws; float* al_l = ws + 32;
  unsigned koff[NKP], kstr[NKP], voff[2];
#pragma unroll
  for (int i = 0; i < NKP; ++i) { const int p = (wid + 8 * i) * 64 + lane;
    if constexpr (!ROPE) { const int row = p >> 4, ch = (p & 15) ^ (row & 15); koff[i] = (unsigned)((const char*)Kh - wsb) + (unsigned)(row * LDK + ch * 8) * 2u; kstr[i] = 64u * LDK * 2u; }
    else { const int row = p / 24, chp = p - row * 24;
      if (chp < 16) { koff[i] = (unsigned)((const char*)Kh - wsb) + (unsigned)(row * LDK + ((chp ^ (row & 15)) * 8)) * 2u; kstr[i] = 64u * LDK * 2u; }
      else { koff[i] = (unsigned)((const char*)Kr - wsb) + (unsigned)(row * LDKR + (((chp - 16) ^ ((row >> 1) & 7)) * 8)) * 2u; kstr[i] = 64u * LDKR * 2u; } } }
#pragma unroll
  for (int i = 0; i < 2; ++i) { const int b = ((wid + 8 * i) * 64 + lane) * 16, st = b >> 9, wb = b & 511, kk = (st >> 2) * 8 + (wb >> 6), c = (st & 3) * 32 + ((wb & 63) >> 1);
    const int k = (kk & ~0xC) | ((kk & 4) << 1) | ((kk & 8) >> 1); voff[i] = (unsigned)((const char*)Vh - wsb) + (unsigned)(k * LDV + c) * 2u; }
#define DMA_K(slotoff) do { _Pragma("unroll") for (int i_ = 0; i_ < NKP; ++i_) \
    __builtin_amdgcn_global_load_lds((const unsigned*)(wsb + koff[i_]), (__attribute__((address_space(3))) unsigned*)(l3 + OFF_K + (slotoff) + (wu + 8 * i_) * 1024), 16, 0, 0); } while (0)
#define DMA_V(slotoff) do { _Pragma("unroll") for (int i_ = 0; i_ < 2; ++i_) \
    __builtin_amdgcn_global_load_lds((const unsigned*)(wsb + voff[i_]), (__attribute__((address_space(3))) unsigned*)(l3 + (slotoff) + (wu + 8 * i_) * 1024), 16, 0, 0); } while (0)
#define ADV_K() do { _Pragma("unroll") for (int i_ = 0; i_ < NKP; ++i_) koff[i_] += kstr[i_]; } while (0)
#define ADV_V() do { voff[0] += 64u * LDV * 2u; voff[1] += 64u * LDV * 2u; } while (0)
#define WAITBAR(N) asm volatile("s_waitcnt vmcnt(" #N ") lgkmcnt(0)\n\ts_barrier" ::: "memory")
  float m_reg = -1e30f, l_reg = 0; f32x16 o[4] = {}; bf16x8 qr[QREG];
  constexpr int QL = DQK / 16 - QREG, QSTR = QL * 32 + 16;
  char* ql = lds + OFF_Q + (wid * QBLK + r32) * QSTR + hi * 16;
  DMA_K(0); ADV_K(); DMA_V(0); ADV_V(); DMA_K(SHM_K); ADV_K();
  const bf16* Qw = Qb + (long)(wid * QBLK + r32) * LDQ + hi * 8;
#pragma unroll
  for (int d0 = 0; d0 < DQK / 16; ++d0) { const bf16x8 t = *reinterpret_cast<const bf16x8*>(Qw + d0 * 16); if (d0 < QREG) qr[d0] = t; else *reinterpret_cast<bf16x8*>(ql + (d0 - QREG) * 32) = t; }
  const int vb0 = (int)(uintptr_t)V_lds + v_rd_base(lane);
#define RESC(a) do { if (__any((a) < 1.f)) { if (hi == 0) al_l[r32] = (a); asm volatile("s_waitcnt lgkmcnt(0)" ::: "memory"); \
    _Pragma("unroll") for (int d = 0; d < 4; ++d) _Pragma("unroll") for (int r = 0; r < 16; ++r) o[d][r] *= al_l[crow(r, hi)]; } } while (0)
  f32x16 pA0, pA1, pB0, pB1; float mnA, mnB, alA, alB; bf16x8 pa0, pa1, pa2, pa3; const int NT = seq / KVBLK;
  WAITBAR(0);
  int ks_cur = 0, ks_nxt = SHM_K, ks_prv = 2 * SHM_K;
  int vs_prv = 2 * SHM_V, vs_cur = 0, vs_nxt = SHM_V;
#define ROTK() do { const int t_ = ks_cur; ks_cur = ks_nxt; ks_nxt = ks_prv; ks_prv = t_; } while (0)
#define ROTV() do { const int t_ = vs_prv; vs_prv = vs_cur; vs_cur = vs_nxt; vs_nxt = t_; } while (0)
  DMA_K(__builtin_amdgcn_readfirstlane(ks_prv)); ADV_K(); DMA_V(__builtin_amdgcn_readfirstlane(vs_nxt)); ADV_V();
  qkt<DQK, QREG>(pA0, pA1, K_lds + ks_cur, qr, ql, r32, hi); partialSM<DQK>(pA0, pA1, m_reg, mnA, alA);
  if constexpr (ROPE) WAITBAR(5); else WAITBAR(4);
  ROTK(); ROTV();
#define STEP(PN0, PN1, PO0, PO1, MN, ALN, ALO) do { \
    DMA_K(__builtin_amdgcn_readfirstlane(ks_prv)); ADV_K(); DMA_V(__builtin_amdgcn_readfirstlane(vs_nxt)); ADV_V(); \
    SBAR(); qkt<DQK, QREG>(PN0, PN1, K_lds + ks_cur, qr, ql, r32, hi); \
    finishSM(PO0, PO1, ALO, l_reg, pa0, pa1, pa2, pa3); SBAR(); \
    pv_d0(o, vb0 + vs_prv, pa0, pa1, pa2, pa3); partialSM<DQK>(PN0, PN1, m_reg, MN, ALN); \
    RESC(ALN); \
    if constexpr (ROPE) WAITBAR(5); else WAITBAR(4); \
    ROTK(); ROTV(); } while (0)
  for (int j = 1; j + 1 < NT; j += 2) {
    STEP(pB0, pB1, pA0, pA1, mnB, alB, alA);
    STEP(pA0, pA1, pB0, pB1, mnA, alA, alB);
  }
  STEP(pB0, pB1, pA0, pA1, mnB, alB, alA);
  finishSM(pB0, pB1, alB, l_reg, pa0, pa1, pa2, pa3); SBAR();
  pv_d0(o, vb0 + vs_prv, pa0, pa1, pa2, pa3);
  if (hi == 0) li_l[r32] = l_reg; asm volatile("s_waitcnt lgkmcnt(0)" ::: "memory");
  float rli[16];
#pragma unroll
  for (int r = 0; r < 16; ++r) rli[r] = __builtin_amdgcn_rcpf(li_l[crow(r, hi)]);
  bf16* Ow = Ob + (long)(wid * QBLK) * LDO;
#pragma unroll
  for (int r = 0; r < 16; ++r) { int orow = crow(r, hi);
#pragma unroll
    for (int d0 = 0; d0 < 4; ++d0) { const float v = o[d0][r] * rli[r]; Ow[(long)orow * LDO + d0 * 32 + r32] = (bf16)(cvtpk(v, v) & 0xffffu); } }
  WAITBAR(0);
#undef DMA_K
#undef DMA_V
#undef ADV_K
#undef ADV_V
#undef WAITBAR
#undef RESC
#undef ROTK
#undef ROTV
#undef STEP
}
template <int DQK, int QREG, bool FAST, int LDQ, int LDK, int LDKR, int LDV, int LDO, bool QFUSE = false>
__device__ __forceinline__ void attn_unit_stag(const bf16* __restrict__ Qb, const bf16* __restrict__ Kh, const bf16* __restrict__ Kr, const bf16* __restrict__ Vh,
                                              bf16* __restrict__ Ob, int seq, char* lds, __attribute__((address_space(3))) unsigned char* l3, const char* wsb, int wv, const float* qgain = nullptr, const float* ctab = nullptr, const float* stab = nullptr, int t0 = 0, float qpre = 1.f) {
  using CF = Cfg<DQK>;
  constexpr int SHM_V = CF::SHM_V, SHM_K = CF::SHM_K; constexpr bool ROPE = (DQK == 192);
  constexpr int NKP = SHM_K / 8192;
  constexpr int OFF_K = 3 * SHM_V, OFF_WS = OFF_K + 3 * SHM_K, OFF_Q = OFF_WS + NW * 64 * 4;
  int tid = wv * 64 + mk_lane_id(); asm volatile("" : "+v"(tid));
  const int wid = tid >> 6, lane = tid & 63, r32 = lane & 31, hi = lane >> 5;
  const int wu = __builtin_amdgcn_readfirstlane(wid);
  char* V_lds = lds; char* K_lds = lds + OFF_K;
  float* ws = (float*)(lds + OFF_WS) + wid * 64; float* li_l = ws; float* al_l = ws + 32;
  unsigned koff[NKP], voff[2]; bool kn[NKP];
#pragma unroll
  for (int i = 0; i < NKP; ++i) { const int p = (wid + 8 * i) * 64 + lane;
    if constexpr (!ROPE) { const int row = p >> 4, ch = (p & 15) ^ (row & 15); koff[i] = (unsigned)((const char*)Kh - wsb) + (unsigned)(row * LDK + ch * 8) * 2u; kn[i] = true; }
    else { const int row = p / 24, chp = p - row * 24;
      kn[i] = chp < 16;
      if (chp < 16) { koff[i] = (unsigned)((const char*)Kh - wsb) + (unsigned)(row * LDK + ((chp ^ (row & 15)) * 8)) * 2u; }
      else { koff[i] = (unsigned)((const char*)Kr - wsb) + (unsigned)(row * LDKR + (((chp - 16) ^ ((row >> 1) & 7)) * 8)) * 2u; } } }
#pragma unroll
  for (int i = 0; i < 2; ++i) { const int b = ((wid + 8 * i) * 64 + lane) * 16, st = b >> 9, wb = b & 511, kk = (st >> 2) * 8 + (wb >> 6), c = (st & 3) * 32 + ((wb & 63) >> 1);
    const int k = (kk & ~0xC) | ((kk & 4) << 1) | ((kk & 8) >> 1); voff[i] = (unsigned)((const char*)Vh - wsb) + (unsigned)(k * LDV + c) * 2u; }
#define DMA_K(slotoff) do { _Pragma("unroll") for (int i_ = 0; i_ < NKP; ++i_) \
    __builtin_amdgcn_global_load_lds((const unsigned*)(wsb + koff[i_]), (__attribute__((address_space(3))) unsigned*)(l3 + OFF_K + (slotoff) + (wu + 8 * i_) * 1024), 16, 0, 0); } while (0)
#define DMA_V(slotoff) do { _Pragma("unroll") for (int i_ = 0; i_ < 2; ++i_) \
    __builtin_amdgcn_global_load_lds((const unsigned*)(wsb + voff[i_]), (__attribute__((address_space(3))) unsigned*)(l3 + (slotoff) + (wu + 8 * i_) * 1024), 16, 0, 0); } while (0)
#define ADV_K() do { _Pragma("unroll") for (int i_ = 0; i_ < NKP; ++i_) koff[i_] += (!ROPE || kn[i_]) ? 64u * LDK * 2u : 64u * LDKR * 2u; } while (0)
#define ADV_V() do { voff[0] += 64u * LDV * 2u; voff[1] += 64u * LDV * 2u; } while (0)
#define WAITBAR(N) asm volatile("s_waitcnt vmcnt(" #N ") lgkmcnt(0)\n\ts_barrier" ::: "memory")
  float m_reg = -1e30f, l_reg = 0; f32x16 o[4] = {}; bf16x8 qr[QREG];
  constexpr int QL = DQK / 16 - QREG, QSTR = QL * 32 + 16;
  char* ql = lds + OFF_Q + (wid * QBLK + r32) * QSTR + hi * 16;
  DMA_K(0); ADV_K(); DMA_V(0); ADV_V(); DMA_K(SHM_K); ADV_K();
  const bf16* Qw = Qb + (long)(wid * QBLK + r32) * LDQ + hi * 8;
  if constexpr (QFUSE) {
    static_assert(!QFUSE || (DQK == 128 && QREG == 8), "fused q norm/rope: D 128, all fragments in registers");
    u32x4 raw[8]; float ss = 0.f;
#pragma unroll
    for (int d0 = 0; d0 < 8; ++d0) { raw[d0] = *reinterpret_cast<const u32x4*>(Qw + d0 * 16);
#pragma unroll
      for (int j = 0; j < 4; ++j) { const float lo = __uint_as_float(raw[d0][j] << 16), hh = __uint_as_float(raw[d0][j] & 0xffff0000u); ss += lo * lo + hh * hh; } }
    { auto rr = __builtin_amdgcn_permlane32_swap(__float_as_uint(ss), __float_as_uint(ss), false, false); ss = __uint_as_float(rr[0]) + __uint_as_float(rr[1]); }
    const float rinv = qpre / sqrtf(ss * (1.f / 128.f) + 1e-6f);
    const int tq = t0 + wid * QBLK + r32, prow = tq >> 6, pcol = tq & 63;
#pragma unroll
    for (int d0 = 0; d0 < 8; ++d0) { const int c0 = d0 * 16 + hi * 8, i0 = c0 >> 1, pos = (d0 < 4) ? prow : pcol, f0 = i0 & 31;
      const f32x4 g0 = *reinterpret_cast<const f32x4*>(qgain + c0), g1 = *reinterpret_cast<const f32x4*>(qgain + c0 + 4);
      const f32x4 cs = *reinterpret_cast<const f32x4*>(ctab + pos * 32 + f0), sn = *reinterpret_cast<const f32x4*>(stab + pos * 32 + f0);
      float x[8];
#pragma unroll
      for (int j = 0; j < 4; ++j) { x[2 * j] = __uint_as_float(raw[d0][j] << 16); x[2 * j + 1] = __uint_as_float(raw[d0][j] & 0xffff0000u); }
      x[0] *= rinv * g0[0]; x[1] *= rinv * g0[1]; x[2] *= rinv * g0[2]; x[3] *= rinv * g0[3]; x[4] *= rinv * g1[0]; x[5] *= rinv * g1[1]; x[6] *= rinv * g1[2]; x[7] *= rinv * g1[3];
      u32x4 w;
#pragma unroll
      for (int j = 0; j < 4; ++j) w[j] = cvtpk(x[2 * j] * cs[j] - x[2 * j + 1] * sn[j], x[2 * j] * sn[j] + x[2 * j + 1] * cs[j]);
      qr[d0] = *reinterpret_cast<bf16x8*>(&w); }
  } else {
#pragma unroll
  for (int d0 = 0; d0 < DQK / 16; ++d0) { const bf16x8 t = *reinterpret_cast<const bf16x8*>(Qw + d0 * 16); if (d0 < QREG) qr[d0] = t; else *reinterpret_cast<bf16x8*>(ql + (d0 - QREG) * 32) = t; }
  }
  const int vb0 = (int)(uintptr_t)V_lds + v_rd_base(lane);
#define RESC(a) do { if (__any((a) < 1.f)) { if (hi == 0) al_l[r32] = (a); asm volatile("s_waitcnt lgkmcnt(0)" ::: "memory"); \
    _Pragma("unroll") for (int d = 0; d < 4; ++d) _Pragma("unroll") for (int r = 0; r < 16; ++r) o[d][r] *= al_l[crow(r, hi)]; } } while (0)
  f32x16 pA0, pA1, pB0, pB1; float mnA, mnB, alA, alB; bf16x8 pa0, pa1, pa2, pa3; const int NT = seq / KVBLK;
  WAITBAR(0);
  int ks_cur = 0, ks_nxt = SHM_K, ks_prv = 2 * SHM_K;
  int vs_prv = 2 * SHM_V, vs_cur = 0, vs_nxt = SHM_V;
#define ROTK() do { const int t_ = ks_cur; ks_cur = ks_nxt; ks_nxt = ks_prv; ks_prv = t_; } while (0)
#define ROTV() do { const int t_ = vs_prv; vs_prv = vs_cur; vs_cur = vs_nxt; vs_nxt = t_; } while (0)
  DMA_K(__builtin_amdgcn_readfirstlane(ks_prv)); ADV_K(); DMA_V(__builtin_amdgcn_readfirstlane(vs_nxt)); ADV_V();
  qkt<DQK, QREG>(pA0, pA1, K_lds + ks_cur, qr, ql, r32, hi);
  if constexpr (FAST) { partialSM_fast(pA0); alA = 1.f; } else partialSM<DQK>(pA0, pA1, m_reg, mnA, alA);
  if constexpr (ROPE) WAITBAR(5); else WAITBAR(4);
  ROTK(); ROTV();
#define WB() do { if constexpr (ROPE) WAITBAR(5); else WAITBAR(4); } while (0)
#define H1(PN0, PN1, PO0, PO1, ALO) do { \
    DMA_K(__builtin_amdgcn_readfirstlane(ks_prv)); ADV_K(); \
    SBAR(); qkt<DQK, QREG>(PN0, PN1, K_lds + ks_cur, qr, ql, r32, hi); \
    finishSM(PO0, PO1, ALO, l_reg, pa0, pa1, pa2, pa3); SBAR(); WB(); } while (0)
#define H2(PN0, PN1, MN, ALN) do { \
    DMA_V(__builtin_amdgcn_readfirstlane(vs_nxt)); ADV_V(); \
    SBAR(); pv_d0(o, vb0 + vs_prv, pa0, pa1, pa2, pa3); \
    if constexpr (FAST) { partialSM_fast(PN0); ALN = 1.f; } else { partialSM<DQK>(PN0, PN1, m_reg, MN, ALN); RESC(ALN); } \
    WB(); ROTK(); ROTV(); } while (0)
  const bool lag = wu >= 4;
  if (lag) WB();
  for (int j = 1; j + 1 < NT; j += 2) {
    H1(pB0, pB1, pA0, pA1, alA); H2(pB0, pB1, mnB, alB);
    H1(pA0, pA1, pB0, pB1, alB); H2(pA0, pA1, mnA, alA);
  }
  H1(pB0, pB1, pA0, pA1, alA); H2(pB0, pB1, mnB, alB);
  if (!lag) WB();
  finishSM(pB0, pB1, alB, l_reg, pa0, pa1, pa2, pa3); SBAR();
  pv_d0(o, vb0 + vs_prv, pa0, pa1, pa2, pa3);
  {
    int tid2 = wv * 64 + mk_lane_id(); asm volatile("" : "+v"(tid2));
    const int wid2 = tid2 >> 6, r32b = tid2 & 31, hib = (tid2 >> 5) & 1;
    float* li2 = (float*)(lds + OFF_WS) + wid2 * 64;
    if (hib == 0) li2[r32b] = l_reg; asm volatile("s_waitcnt lgkmcnt(0)" ::: "memory");
    bf16* Ow = Ob + (long)(wid2 * QBLK) * LDO + r32b;
#pragma unroll
    for (int r = 0; r < 16; ++r) { const int orow = crow(r, hib); const float rl = __builtin_amdgcn_rcpf(li2[orow]);
#pragma unroll
      for (int d0 = 0; d0 < 4; ++d0) { const float v = o[d0][r] * rl; Ow[(long)orow * LDO + d0 * 32] = (bf16)(cvtpk(v, v) & 0xffffu); } }
  }
  WAITBAR(0);
#undef DMA_K
#undef DMA_V
#undef ADV_K
#undef ADV_V
#undef WAITBAR
#undef RESC
#undef ROTK
#undef ROTV
#undef H1
#undef H2
#undef WB
}
#undef SBAR
}

#define LAS __attribute__((address_space(3)))
typedef unsigned short bf16;
typedef unsigned v4u __attribute__((ext_vector_type(4)));
typedef unsigned v2u __attribute__((ext_vector_type(2)));
typedef float f32x4 __attribute__((ext_vector_type(4)));
constexpr int NWAVES = 8;
constexpr int LDS_BYTES = 163840;
constexpr int NPHASES = 12;

__device__ __forceinline__ unsigned f2bf(float f) { unsigned u = __builtin_bit_cast(unsigned, f); return (u + 0x7fffu + ((u >> 16) & 1u)) >> 16; }
__device__ __forceinline__ unsigned pk2(float lo, float hi) { return f2bf(lo) | (f2bf(hi) << 16); }
__device__ __forceinline__ float bflo(unsigned w) { return __uint_as_float(w << 16); }
__device__ __forceinline__ float bfhi(unsigned w) { return __uint_as_float(w & 0xffff0000u); }
__device__ __forceinline__ float wave_sum(float v) {
#pragma unroll
    for (int o = 1; o < 64; o <<= 1) v += __shfl_xor(v, o);
    return v;
}


#define XB_TMO      128
#define XB_XCNT(j)  (256  + 64 * (j))
#define XB_XSUB(j)  (1280 + 64 * (j))
#define XB_XGEN(j)  (2304 + 64 * (j))
#define XB_TOP      3328
#define XB_TOPGEN   3392
#define XCD_BAR_WORDS 3456
#define XB_SPIN_CAP (1u << 18)
__device__ __forceinline__ unsigned xb_ld(unsigned* p)              { return __hip_atomic_load(p, __ATOMIC_RELAXED, __HIP_MEMORY_SCOPE_AGENT); }
__device__ __forceinline__ unsigned xb_add(unsigned* p, unsigned v) { return __hip_atomic_fetch_add(p, v, __ATOMIC_RELAXED, __HIP_MEMORY_SCOPE_AGENT); }
__device__ __forceinline__ unsigned xb_xcc_id() { return (unsigned)__builtin_amdgcn_s_getreg((3 << 11) | 20) & 0xFu; }
#define XB_SPIN(cond, bar) do { unsigned _sp = 0; while (cond) { __builtin_amdgcn_s_sleep(1); \
    if ((++_sp & 255u) == 0u) { if (xb_ld(&(bar)[XB_TMO])) break; if (_sp > XB_SPIN_CAP) { atomicAdd(&(bar)[XB_TMO], 1u); break; } } } } while (0)
struct XcdBarrier { unsigned* bar; unsigned x; volatile LAS unsigned* st; int wv; };
__device__ __forceinline__ XcdBarrier xcd_barrier_post(unsigned* bar, volatile LAS unsigned* st) {
    XcdBarrier b; b.bar = bar; b.x = xb_xcc_id(); b.st = st; b.wv = 0;
    if (threadIdx.x == 0) (void)xb_add(&bar[XB_XCNT(b.x)], 1u);
    return b;
}
__device__ __forceinline__ void xcd_barrier_complete(unsigned* bar, unsigned x, unsigned& nloc, unsigned& nx) {
    const unsigned G = gridDim.x * gridDim.y * gridDim.z;
    unsigned sum, cnt, mine, sp = 0u;
    for (;;) {
        sum = 0u; cnt = 0u; mine = 0u;
#pragma unroll
        for (unsigned j = 0; j < 16; ++j) { const unsigned c = xb_ld(&bar[XB_XCNT(j)]); sum += c; cnt += (c > 0u) ? 1u : 0u; mine = (j == x) ? c : mine; }
        if (sum == G) break;
        __builtin_amdgcn_s_sleep(1);
        if ((++sp & 255u) == 0u) { if (xb_ld(&bar[XB_TMO])) break; if (sp > XB_SPIN_CAP) { atomicAdd(&bar[XB_TMO], 1u); break; } }
    }
    nloc = mine > 0u ? mine : 1u; nx = cnt > 0u ? cnt : 1u;
}
__device__ __forceinline__ void xcd_barrier(const XcdBarrier& b) {
    asm volatile("s_waitcnt vmcnt(0)" ::: "memory");
    __syncthreads();
    if (b.wv == 0 && mk_lane_id() == 0) {
        unsigned* bar = b.bar;
        __builtin_amdgcn_s_waitcnt(0);
        unsigned nloc = b.st[0], nx = b.st[1];
        if (nloc == 0u) { xcd_barrier_complete(bar, b.x, nloc, nx); b.st[0] = nloc; b.st[1] = nx; }
        const unsigned old = xb_add(&bar[XB_XSUB(b.x)], 1u);
        const unsigned gen = old / nloc;
        if (old + 1u == (gen + 1u) * nloc) {
            __builtin_amdgcn_fence(__ATOMIC_RELEASE, "agent");
            asm volatile("s_waitcnt vmcnt(0)" ::: "memory");
            const unsigned og = xb_add(&bar[XB_TOP], 1u);
            const unsigned tg = og / nx;
            if (og + 1u == (tg + 1u) * nx) xb_add(&bar[XB_TOPGEN], 1u);
            else XB_SPIN(xb_ld(&bar[XB_TOPGEN]) == tg, bar);
            __builtin_amdgcn_fence(__ATOMIC_ACQUIRE, "agent");
            xb_add(&bar[XB_XGEN(b.x)], 1u);
            asm volatile("s_waitcnt vmcnt(0)" ::: "memory");
        } else {
            XB_SPIN(xb_ld(&bar[XB_XGEN(b.x)]) == gen, bar);
            __builtin_amdgcn_fence(__ATOMIC_ACQUIRE, "agent");
            asm volatile("s_waitcnt vmcnt(0)" ::: "memory");
        }
    }
    __syncthreads();
}

struct Args {
    const float* x; const float* c; const float* w_ada; const float* b_ada; const float* w_in; const float* b_gates;
    const float* gqa_q_gain; const float* gqa_k_gain; const float* mla_q_gain; const float* mla_kv_gain;
    const float* w_mla_uq; const float* w_mla_ukv; const float* w_branch_gqa; const float* w_branch_mla; const float* w_out;
    const float* ln1_g; const float* ln1_b; const float* w_ffn_gate; const float* w_ffn_up; const float* w_ffn_down; const float* ln2_g; const float* ln2_b;
    float* out; unsigned char* ws; int ph_lo, ph_hi;
};

__device__ __forceinline__ void tr_item(const float* W, int ldw, int k0, int sn0, bf16* WT, int ldt, int drow0, const float* ks, bool zero, LAS float* scr, int lane) {
    float t[32];
    const float* src = W + (size_t)(k0 + (lane >> 5)) * ldw + sn0 + (lane & 31);
#pragma unroll
    for (int i = 0; i < 32; ++i) t[i] = zero ? 0.f : __builtin_nontemporal_load(src + (size_t)(2 * i) * ldw);
    if (ks) {
#pragma unroll
        for (int i = 0; i < 32; ++i) t[i] *= ks[k0 + 2 * i + (lane >> 5)]; }
#pragma unroll
    for (int i = 0; i < 32; ++i) scr[(2 * i + (lane >> 5)) * 33 + (lane & 31)] = t[i];
    asm volatile("s_waitcnt lgkmcnt(0)" ::: "memory");
    const int c = lane & 7;
#pragma unroll
    for (int j = 0; j < 4; ++j) { const int n = (lane >> 3) + 8 * j; const LAS float* s = scr + (8 * c) * 33 + n;
        v4u o; o.x = pk2(s[0 * 33], s[1 * 33]); o.y = pk2(s[2 * 33], s[3 * 33]); o.z = pk2(s[4 * 33], s[5 * 33]); o.w = pk2(s[6 * 33], s[7 * 33]);
        *(v4u*)(WT + (size_t)(drow0 + n) * ldt + k0 + 8 * c) = o; }
    asm volatile("s_waitcnt lgkmcnt(0)" ::: "memory");
}

__global__ void __launch_bounds__(NWAVES * 64, 2) mk_fwd(Args a) {
    extern __shared__ __attribute__((aligned(16))) unsigned char lds[];
    cg::grid_group grid = cg::this_grid();
    const int tid = threadIdx.x;
    const int wave_s = __builtin_amdgcn_readfirstlane(tid >> 6);
    const int G = gridDim.x;
    const int NGW = G * NWAVES;
#define PHASE_IDS int tid_ = wave_s * 64 + mk_lane_id(); asm volatile("" : "+v"(tid_)); const int lane = tid_ & 63; const int wave = wave_s; const int gw = blockIdx.x * NWAVES + wave; (void)lane; (void)gw;
    unsigned char* ws = a.ws;
    float* MOD = (float*)(ws + WS_MOD);
    float* CGt = (float*)(ws + WS_TAB); float* SGt = CGt + 128 * 32; float* CMt = SGt + 128 * 32; float* SMt = CMt + 128 * 16;
    float* RINVQ = (float*)(ws + WS_RINV); float* RINVKV = RINVQ + M;
    unsigned* NRM = (unsigned*)(ws + WS_CTL) + 96;
    bf16* WIN = (bf16*)(ws + WS_WIN); bf16* WUQ = (bf16*)(ws + WS_WUQ); bf16* WUKV = (bf16*)(ws + WS_WUKV); bf16* WBG = (bf16*)(ws + WS_WBG); bf16* WBM = (bf16*)(ws + WS_WBM);
    bf16* WOUT = (bf16*)(ws + WS_WOUT); bf16* WGU = (bf16*)(ws + WS_WGU); bf16* WDN = (bf16*)(ws + WS_WDN);
    bf16* H = (bf16*)(ws + WS_H); bf16* QM = H; bf16* PROJ = (bf16*)(ws + WS_PROJ); bf16* ACT = PROJ; bf16* KV = (bf16*)(ws + WS_KV); bf16* T1 = KV; bf16* YATT = (bf16*)(ws + WS_YATT);
    const int lo = a.ph_lo, hi = a.ph_hi;
#ifndef PH_MASK
#define PH_MASK 0xffff
#endif
#define IN(k) (((PH_MASK >> (k)) & 1) && lo <= (k) && (k) < hi)
    volatile LAS unsigned* MISC = (volatile LAS unsigned*)((LAS unsigned char*)lds + LDS_BYTES - 128);
    if (tid < 32) MISC[tid] = 0u;
    __syncthreads();
    XcdBarrier bar = xcd_barrier_post((unsigned*)(ws + WS_CTL) + 4096, MISC + 8); bar.wv = wave_s;
    if (hi > 1000) grid.sync();
#define SEAM(k) do { if (lo <= (k) && (k) + 1 < hi) xcd_barrier(bar); } while (0)

    if (IN(0)) { PHASE_IDS
        LAS float* scr = (LAS float*)((LAS unsigned char*)lds + wave * 16384);
        constexpr int I_ADA = 48 * 32;
        constexpr int I_IN = 32 * 216, I_UQ = 8 * 48, I_UKV = 8 * 64, I_BG = 16 * 64, I_OUT = 32 * 64, I_G = 32 * 176, I_DN = 88 * 64;
        constexpr int NITEMS = I_ADA + I_IN + I_UQ + I_UKV + 2 * I_BG + I_OUT;
        (void)I_G; (void)I_DN;
        if (gw < 128) {
            const float pos = (float)gw;
            if (lane < 32) { const float f = powf(10000.f, -(float)lane / 32.f); const float ang = pos * f; CGt[gw * 32 + lane] = cosf(ang); SGt[gw * 32 + lane] = sinf(ang); }
            else if (lane < 48) { const int i = lane - 32; const float f = powf(10000.f, -(float)i / 16.f); const float ang = pos * f; CMt[gw * 16 + i] = cosf(ang); SMt[gw * 16 + i] = sinf(ang); }
        }
        for (int rep = 0; rep < PROBE_P0; ++rep)
        for (int it = gw + (rep ? ((I_ADA + NGW - 1) / NGW) * NGW : 0); it < NITEMS; it += NGW) {
            int r = it;
            if (r < I_ADA) {
                const int jc = r % 48, kc = r / 48, j0 = jc * 256 + lane * 4, k0 = kc * 64;
                float sb[4];
#pragma unroll
                for (int b = 0; b < 4; ++b) { const float cv = a.c[b * DM + k0 + lane]; sb[b] = cv / (1.f + __expf(-cv)); }
                f32x4 acc[4];
#pragma unroll
                for (int b = 0; b < 4; ++b) acc[b] = (f32x4){0.f, 0.f, 0.f, 0.f};
#pragma unroll 16
                for (int kk = 0; kk < 64; ++kk) { const f32x4 w = __builtin_nontemporal_load((const f32x4*)(a.w_ada + (size_t)(k0 + kk) * (6 * DM) + j0));
#pragma unroll
                    for (int b = 0; b < 4; ++b) { const float s = __shfl(sb[b], kk); acc[b] += w * s; } }
                if (kc == 0) { const f32x4 bb = *(const f32x4*)(a.b_ada + j0);
#pragma unroll
                    for (int b = 0; b < 4; ++b) acc[b] += bb; }
#pragma unroll
                for (int b = 0; b < 4; ++b)
#pragma unroll
                    for (int j = 0; j < 4; ++j) atomicAdd(MOD + b * (6 * DM) + j0 + j, acc[b][j]);
                continue; }
            r -= I_ADA;
            if (r < I_IN) { const int kb = r / 216, nb = r % 216, n0 = nb * 32; const bool z = n0 >= 6720; const int sn0 = n0 < 2560 ? n0 : (n0 < 6656 ? n0 + 64 : (z ? 0 : n0 - 6656 + 2560));
                tr_item(a.w_in, 6720, kb * 64, sn0, WIN, DM, n0, nullptr, z, scr, lane); continue; }
            r -= I_IN;
            if (r < I_UQ) { const int kb = r / 48, nb = r % 48; tr_item(a.w_mla_uq, 1536, kb * 64, nb * 32, WUQ, 512, nb * 32, a.mla_q_gain, false, scr, lane); continue; }
            r -= I_UQ;
            if (r < I_UKV) { const int kb = r / 64, nb = r % 64; tr_item(a.w_mla_ukv, 2048, kb * 64, nb * 32, WUKV, 512, nb * 32, a.mla_kv_gain, false, scr, lane); continue; }
            r -= I_UKV;
            if (r < I_BG) { const int kb = r / 64, nb = r % 64; tr_item(a.w_branch_gqa, DM, kb * 64, nb * 32, WBG, 2048, nb * 32, nullptr, false, scr, lane); continue; }
            r -= I_BG;
            if (r < I_BG) { const int kb = r / 64, nb = r % 64; tr_item(a.w_branch_mla, DM, kb * 64, nb * 32, WBG + 1024, 2048, nb * 32, nullptr, false, scr, lane); continue; }
            r -= I_BG;
            { const int kb = r / 64, nb = r % 64; tr_item(a.w_out, DM, kb * 64, nb * 32, WOUT, DM, nb * 32, nullptr, false, scr, lane); }
        }
    }
    SEAM(0);

    if (IN(1)) for (int rep = 0; rep < PROBE_P1; ++rep) { PHASE_IDS
        constexpr int RB = 4;
        for (int m0 = gw * RB; m0 < M; m0 += NGW * RB) {
            const float* mod = MOD + (size_t)(m0 >> 13) * (6 * DM);
            f32x4 v[RB][8];
#pragma unroll
            for (int r = 0; r < RB; ++r) { const f32x4* xr = (const f32x4*)(a.x + (size_t)(m0 + r) * DM) + lane;
#pragma unroll
                for (int j = 0; j < 8; ++j) v[r][j] = __builtin_nontemporal_load(xr + 64 * j); }
#pragma unroll
            for (int r = 0; r < RB; ++r) {
                float s = 0.f;
#pragma unroll
                for (int j = 0; j < 8; ++j) s += (v[r][j].x + v[r][j].y) + (v[r][j].z + v[r][j].w);
                const float mean = wave_sum(s) * (1.f / DM); float s2 = 0.f;
#pragma unroll
                for (int j = 0; j < 8; ++j) { v[r][j] = v[r][j] - mean; s2 += (v[r][j].x * v[r][j].x + v[r][j].y * v[r][j].y) + (v[r][j].z * v[r][j].z + v[r][j].w * v[r][j].w); }
                const float rstd = 1.f / sqrtf(wave_sum(s2) * (1.f / DM) + LN_EPS);
                v2u* o8 = (v2u*)(H + (size_t)(m0 + r) * DM) + lane;
#pragma unroll
                for (int j = 0; j < 8; ++j) { const int col = 4 * (lane + 64 * j); const f32x4 sh = *(const f32x4*)(mod + col), sc = *(const f32x4*)(mod + DM + col);
                    const f32x4 h = v[r][j] * rstd * (sc + 1.f) + sh; v2u w; w.x = pk2(h.x, h.y); w.y = pk2(h.z, h.w); o8[64 * j] = w; }
            }
        }
    }
    SEAM(1);

    if (IN(2)) for (int rep = 0; rep < PROBE_GEMM; ++rep) {
        pg8::Gemm g{H, WIN, DM, M, NPROJ, DM}; pg8::StaticOrder S; S.init(M, NPROJ, G, (int)blockIdx.x);
        pg8::EpiInProj E{PROJ, NPROJ, a.b_gates};
        pg8::gemm_phase<pg8::EpiInProj>((LAS unsigned char*)lds, g, S, E, wave_s);
        { PHASE_IDS
          constexpr int NU = (M / 256) * (NPROJ / 256), I_G = 32 * 176, I_DN = 88 * 64, NFFN = 2 * I_G + I_DN;
          const int rem = NU % G; const bool idle = (rem == 0) || ((int)blockIdx.x >= rem);
          const int nidle = (rem == 0) ? G : (G - rem), me = (rem == 0) ? (int)blockIdx.x : ((int)blockIdx.x - rem);
          if (idle) { LAS float* scr = (LAS float*)((LAS unsigned char*)lds + wave * 16384);
            for (int it = me * NWAVES + wave; it < NFFN; it += nidle * NWAVES) { int r = it;
              if (r < I_G) { const int kb = r / 176, nb = r % 176, n0 = nb * 32; tr_item(a.w_ffn_gate, DFF, kb * 64, n0, WGU, DM, (n0 >> 7) * 256 + (n0 & 127), nullptr, false, scr, lane); continue; }
              r -= I_G;
              if (r < I_G) { const int kb = r / 176, nb = r % 176, n0 = nb * 32; tr_item(a.w_ffn_up, DFF, kb * 64, n0, WGU, DM, (n0 >> 7) * 256 + 128 + (n0 & 127), nullptr, false, scr, lane); continue; }
              r -= I_G;
              { const int kb = r / 64, nb = r % 64; tr_item(a.w_ffn_down, DM, kb * 64, nb * 32, WDN, DFF, nb * 32, nullptr, false, scr, lane); } } } }
    }
    SEAM(2);

    if (IN(3)) { PHASE_IDS
        float nq2 = 0.f, nk2 = 0.f, nkr2 = 0.f;
        for (int m = gw; m < M; m += NGW) {
            bf16* pr = PROJ + (size_t)m * NPROJ; const int tp = m & (SEQ - 1), prow = tp >> 6, pcol = tp & 63;
            const int half = lane >> 5, l = lane & 31;
            v2u hw[5];
#pragma unroll
            for (int it = 4; it < 5; ++it) hw[it] = *((const v2u*)(pr + (2 * it + half) * 128) + l);
            const v4u lw0 = *((const v4u*)(pr + PC_QLAT) + lane * 2), lw1 = *((const v4u*)(pr + PC_QLAT) + lane * 2 + 1);
            unsigned kw = 0; if (lane < 32) kw = *((const unsigned*)(pr + PC_KR) + lane);
            const int i0 = 2 * l, pos = (i0 < 32) ? prow : pcol, f0 = i0 & 31;
            const float c0 = CGt[pos * 32 + f0], s0 = SGt[pos * 32 + f0], c1 = CGt[pos * 32 + f0 + 1], s1 = SGt[pos * 32 + f0 + 1];
            const f32x4 gq = *(const f32x4*)(a.gqa_q_gain + 4 * l), gk = *(const f32x4*)(a.gqa_k_gain + 4 * l);
#pragma unroll
            for (int it = 4; it < 5; ++it) {
                const int hd = 2 * it + half; const v2u w = hw[it];
                float x0 = bflo(w.x), x1 = bfhi(w.x), x2 = bflo(w.y), x3 = bfhi(w.y);
                float ss = (x0 * x0 + x1 * x1) + (x2 * x2 + x3 * x3);
#pragma unroll
                for (int o = 1; o < 32; o <<= 1) ss += __shfl_xor(ss, o);
                const float rinv = 1.f / sqrtf(ss * (1.f / 128.f) + RMS_EPS);
                const f32x4 gv = (hd < 8) ? gq : gk; const float pre = (hd < 8) ? CG_PRE : 1.f;
                x0 *= rinv * gv.x * pre; x1 *= rinv * gv.y * pre; x2 *= rinv * gv.z * pre; x3 *= rinv * gv.w * pre;
                { float n2 = (x0 * x0 + x1 * x1) + (x2 * x2 + x3 * x3);
#pragma unroll
                  for (int o = 1; o < 32; o <<= 1) n2 += __shfl_xor(n2, o);
                  if (hd < 8) nq2 = fmaxf(nq2, n2); else nk2 = fmaxf(nk2, n2); }
                v2u o; o.x = pk2(x0 * c0 - x1 * s0, x0 * s0 + x1 * c0); o.y = pk2(x2 * c1 - x3 * s1, x2 * s1 + x3 * c1); *((v2u*)(pr + hd * 128) + l) = o;
            }
            {
                float ss = 0.f;
#pragma unroll
                for (int j = 0; j < 2; ++j) { const v4u w = j ? lw1 : lw0;
                    ss += bflo(w.x) * bflo(w.x) + bfhi(w.x) * bfhi(w.x) + bflo(w.y) * bflo(w.y) + bfhi(w.y) * bfhi(w.y)
                        + bflo(w.z) * bflo(w.z) + bfhi(w.z) * bfhi(w.z) + bflo(w.w) * bflo(w.w) + bfhi(w.w) * bfhi(w.w); }
#pragma unroll
                for (int o = 1; o < 32; o <<= 1) ss += __shfl_xor(ss, o);
                const float rinv = 1.f / sqrtf(ss * (1.f / 512.f) + RMS_EPS);
                if (l == 0) { if (half == 0) RINVQ[m] = rinv; else RINVKV[m] = rinv; }
            }
            { float kr2 = bflo(kw) * bflo(kw) + bfhi(kw) * bfhi(kw);
#pragma unroll
              for (int o = 1; o < 32; o <<= 1) kr2 += __shfl_xor(kr2, o);
              nkr2 = fmaxf(nkr2, kr2); }
            if (lane < 32) {
                const float x0 = bflo(kw), x1 = bfhi(kw);
                const int pos2 = (lane < 16) ? prow : pcol, f = lane & 15; const float c = CMt[pos2 * 16 + f], sn = SMt[pos2 * 16 + f];
                *((unsigned*)(pr + PC_KR) + lane) = pk2(x0 * c - x1 * sn, x0 * sn + x1 * c);
            }
        }
        nq2 = fmaxf(nq2, __shfl_xor(nq2, 32)); nk2 = fmaxf(nk2, __shfl_xor(nk2, 32));
        if (lane == 0) { atomicMax(NRM + 0, __float_as_uint(nq2)); atomicMax(NRM + 1, __float_as_uint(nk2)); atomicMax(NRM + 5, __float_as_uint(nkr2 * 1.02f)); }
    }
    SEAM(3);

    if (IN(4)) for (int rep = 0; rep < PROBE_GEMM; ++rep) {
        { pg8::Gemm g{PROJ + PC_QLAT, WUQ, NPROJ, M, 1536, 512}; pg8::StaticOrder S; S.init(M, 1536, G, (int)blockIdx.x);
          pg8::EpiQM E{QM, 1536, RINVQ, CM_PRE, CMt, SMt, NRM + 2}; pg8::gemm_phase<pg8::EpiQM>((LAS unsigned char*)lds, g, S, E, wave_s); }
        { pg8::Gemm g{PROJ + PC_KVLAT, WUKV, NPROJ, M, 2048, 512}; pg8::StaticOrder S; S.init(M, 2048, G, (int)blockIdx.x);
          pg8::EpiKVNorm E{KV, 2048, RINVKV, NRM + 4}; pg8::gemm_phase<pg8::EpiKVNorm>((LAS unsigned char*)lds, g, S, E, wave_s); }
    }
    SEAM(4);


    if (IN(6)) for (int rep = 0; rep < PROBE_REP6; ++rep) {
#ifndef ATT_ONLY
#define ATT_ONLY 3
#endif
#ifndef GQA_QREG
#define GQA_QREG 8
#endif
#ifndef GQA_SD
#define GQA_SD 2
#endif
#ifndef MLA_QREG_SAFE
#define MLA_QREG_SAFE 12
#endif
#ifndef GQA_QREG_SAFE
#define GQA_QREG_SAFE 8
#endif
#ifndef ATT_FN
#define ATT_FN attn_unit_stag
#endif
#ifndef MLA_SD
#define MLA_SD 1
#endif
#ifndef MLA_QREG
#define MLA_QREG 12
#endif
        float gmx; { PHASE_IDS gmx = fmaxf(fabsf(a.gqa_q_gain[lane]), fabsf(a.gqa_q_gain[lane + 64]));
#pragma unroll
          for (int o = 1; o < 64; o <<= 1) gmx = fmaxf(gmx, __shfl_xor(gmx, o)); }
        const float bnd_g = sqrtf(128.f * 1.02f * (CG_PRE * gmx) * (CG_PRE * gmx) * __uint_as_float(__hip_atomic_load(NRM + 1, __ATOMIC_RELAXED, __HIP_MEMORY_SCOPE_AGENT)));
        const float bnd_m = sqrtf(6.f * __uint_as_float(__hip_atomic_load(NRM + 2, __ATOMIC_RELAXED, __HIP_MEMORY_SCOPE_AGENT)) *
                                  (4.f * __uint_as_float(__hip_atomic_load(NRM + 4, __ATOMIC_RELAXED, __HIP_MEMORY_SCOPE_AGENT)) + __uint_as_float(__hip_atomic_load(NRM + 5, __ATOMIC_RELAXED, __HIP_MEMORY_SCOPE_AGENT))));
        const bool fast_g = __builtin_amdgcn_readfirstlane((int)(bnd_g < 96.f)) != 0, fast_m = __builtin_amdgcn_readfirstlane((int)(bnd_m < 96.f)) != 0;
#define MLA_ARGS QM + (r0 + slot * 256) * 1536 + h * 192, KV + r0 * 2048 + h * 256, PROJ + r0 * NPROJ + PC_KR, KV + r0 * 2048 + h * 256 + 128, YATT + (r0 + slot * 256) * 2048 + 1024 + h * 128, SEQ, (char*)lds, (LAS unsigned char*)lds, (const char*)ws, wave_s
#define MLA_ARGS_OLD QM + (r0 + slot * 256) * 1536 + h * 192, KV + r0 * 2048 + h * 256, PROJ + r0 * NPROJ + PC_KR, KV + r0 * 2048 + h * 256 + 128, YATT + (r0 + slot * 256) * 2048 + 1024 + h * 128, SEQ, (char*)lds, wave_s
#define GQA_ARGS_OLD PROJ + (r0 + slot * 256) * NPROJ + PC_QG + h * 128, PROJ + r0 * NPROJ + PC_KG + kvh * 128, nullptr, PROJ + r0 * NPROJ + PC_VG + kvh * 128, YATT + (r0 + slot * 256) * 2048 + h * 128, SEQ, (char*)lds, wave_s
#define GQA_ARGS PROJ + (r0 + slot * 256) * NPROJ + PC_QG + h * 128, PROJ + r0 * NPROJ + PC_KG + kvh * 128, nullptr, PROJ + r0 * NPROJ + PC_VG + kvh * 128, YATT + (r0 + slot * 256) * 2048 + h * 128, SEQ, (char*)lds, (LAS unsigned char*)lds, (const char*)ws, wave_s
        if (ATT_ONLY & 1) {
          if (fast_m) { for (int u = blockIdx.x; u < 1024; u += G) { const int xcd = u & 7, slot = (u >> 3) & 31, k = u >> 8; const int b = k, h = xcd; const size_t r0 = (size_t)b * SEQ;
              att::attn_unit_stag<192, MLA_QREG, true, 1536, 2048, NPROJ, 2048, 2048>(MLA_ARGS); } }
          else { for (int u = blockIdx.x; u < 1024; u += G) { const int xcd = u & 7, slot = (u >> 3) & 31, k = u >> 8; const int b = k, h = xcd; const size_t r0 = (size_t)b * SEQ;
              att::attn_unit<192, 8, 1, 1536, 2048, NPROJ, 2048, 2048>(MLA_ARGS_OLD); } }
        }
        if (ATT_ONLY & 2) {
          if (fast_g) { for (int u = blockIdx.x; u < 1024; u += G) { const int xcd = u & 7, slot = (u >> 3) & 31, k = u >> 8; const int b = xcd >> 1, kvh = xcd & 1, h = kvh * 4 + k; const size_t r0 = (size_t)b * SEQ;
              att::attn_unit_stag<128, 8, true, NPROJ, NPROJ, NPROJ, NPROJ, 2048, true>(GQA_ARGS, a.gqa_q_gain, CGt, SGt, slot * 256, CG_PRE); } }
          else { for (int u = blockIdx.x; u < 1024; u += G) { const int xcd = u & 7, slot = (u >> 3) & 31, k = u >> 8; const int b = xcd >> 1, kvh = xcd & 1, h = kvh * 4 + k; const size_t r0 = (size_t)b * SEQ;
              att::attn_unit_stag<128, 8, false, NPROJ, NPROJ, NPROJ, NPROJ, 2048, true>(GQA_ARGS, a.gqa_q_gain, CGt, SGt, slot * 256, CG_PRE); } }
        }
#undef MLA_ARGS
#undef GQA_ARGS
    }
    SEAM(6);

    if (IN(7)) for (int rep = 0; rep < PROBE_GEMM; ++rep) {
        { pg8::Gemm g{YATT, WBG, 2048, M, DM, 2048}; pg8::StaticOrder S; S.init(M, DM, G, (int)blockIdx.x);
          pg8::EpiGateMerge E{H, DM, PROJ + PC_GATE, PROJ + PC_GATE + DM, NPROJ}; pg8::gemm_phase<pg8::EpiGateMerge>((LAS unsigned char*)lds, g, S, E, wave_s); }
    }
    SEAM(7);

    if (IN(8)) for (int rep = 0; rep < PROBE_GEMM; ++rep) {
        pg8::Gemm g{H, WOUT, DM, M, DM, DM}; pg8::StaticOrder S; S.init(M, DM, G, (int)blockIdx.x);
        pg8::EpiRowScale E{YATT, DM, nullptr, 1.f}; pg8::gemm_phase<pg8::EpiRowScale>((LAS unsigned char*)lds, g, S, E, wave_s);
    }
    SEAM(8);

    if (IN(9)) { PHASE_IDS
        constexpr int RB = 2;
        for (int m0 = gw * RB; m0 < M; m0 += NGW * RB) {
            const float* mod = MOD + (size_t)(m0 >> 13) * (6 * DM);
            f32x4 v[RB][8];
            v2u uu[RB][8];
#pragma unroll
            for (int r = 0; r < RB; ++r) { const f32x4* xr = (const f32x4*)(a.x + (size_t)(m0 + r) * DM) + lane; const v2u* ur = (const v2u*)(YATT + (size_t)(m0 + r) * DM) + lane;
#pragma unroll
                for (int j = 0; j < 8; ++j) { v[r][j] = __builtin_nontemporal_load(xr + 64 * j); uu[r][j] = ur[64 * j]; } }
#pragma unroll
            for (int r = 0; r < RB; ++r) {
                f32x4* xr = (f32x4*)(a.out + (size_t)(m0 + r) * DM) + lane;
                float s = 0.f;
#pragma unroll
                for (int j = 0; j < 8; ++j) { const f32x4 g1 = *(const f32x4*)(mod + 2 * DM + 4 * (lane + 64 * j)); const v2u w = uu[r][j];
                    v[r][j] = v[r][j] * ALPHA + g1 * (f32x4){bflo(w.x), bfhi(w.x), bflo(w.y), bfhi(w.y)};
                    s += (v[r][j].x + v[r][j].y) + (v[r][j].z + v[r][j].w); }
                float mean = wave_sum(s) * (1.f / DM), s2 = 0.f;
#pragma unroll
                for (int j = 0; j < 8; ++j) { v[r][j] = v[r][j] - mean; s2 += (v[r][j].x * v[r][j].x + v[r][j].y * v[r][j].y) + (v[r][j].z * v[r][j].z + v[r][j].w * v[r][j].w); }
                float rstd = 1.f / sqrtf(wave_sum(s2) * (1.f / DM) + LN_EPS);
                s = 0.f;
#pragma unroll
                for (int j = 0; j < 8; ++j) { const int col = 4 * (lane + 64 * j); const f32x4 gg = *(const f32x4*)(a.ln1_g + col), bb = *(const f32x4*)(a.ln1_b + col);
                    v[r][j] = v[r][j] * rstd * gg + bb; xr[64 * j] = v[r][j]; s += (v[r][j].x + v[r][j].y) + (v[r][j].z + v[r][j].w); }
                mean = wave_sum(s) * (1.f / DM); s2 = 0.f;
#pragma unroll
                for (int j = 0; j < 8; ++j) { v[r][j] = v[r][j] - mean; s2 += (v[r][j].x * v[r][j].x + v[r][j].y * v[r][j].y) + (v[r][j].z * v[r][j].z + v[r][j].w * v[r][j].w); }
                rstd = 1.f / sqrtf(wave_sum(s2) * (1.f / DM) + LN_EPS);
                v2u* o8 = (v2u*)(H + (size_t)(m0 + r) * DM) + lane;
#pragma unroll
                for (int j = 0; j < 8; ++j) { const int col = 4 * (lane + 64 * j); const f32x4 sh = *(const f32x4*)(mod + 3 * DM + col), sc = *(const f32x4*)(mod + 4 * DM + col);
                    const f32x4 h = v[r][j] * rstd * (sc + 1.f) + sh; v2u w; w.x = pk2(h.x, h.y); w.y = pk2(h.z, h.w); o8[64 * j] = w; }
            }
        }
    }
    SEAM(9);

    if (IN(10)) for (int rep = 0; rep < PROBE_REP10; ++rep) {
        pg8::Gemm g{H, WGU, DM, M, 2 * DFF, DM}; pg8::StaticOrder S; S.init(M, 2 * DFF, G, (int)blockIdx.x);
        pg8::EpiSwiGLU E{ACT, DFF}; pg8::gemm_phase<pg8::EpiSwiGLU>((LAS unsigned char*)lds, g, S, E, wave_s);
    }
    SEAM(10);

    if (IN(11)) for (int rep = 0; rep < PROBE_GEMM; ++rep) {
        pg8::Gemm g{ACT, WDN, DFF, M, DM, DFF}; pg8::StaticOrder S; S.init(M, DM, G, (int)blockIdx.x);
        pg8::EpiRowScale E{KV, DM, nullptr, 1.f}; pg8::gemm_phase<pg8::EpiRowScale>((LAS unsigned char*)lds, g, S, E, wave_s);
    }
    SEAM(11);
    if (IN(12)) { PHASE_IDS
        constexpr int RB = 2;
        for (int m0 = gw * RB; m0 < M; m0 += NGW * RB) {
            f32x4 v[RB][8];
            const float* mod = MOD + (size_t)(m0 >> 13) * (6 * DM);
            v2u uu[RB][8];
#pragma unroll
            for (int r = 0; r < RB; ++r) { const f32x4* xr = (const f32x4*)(a.out + (size_t)(m0 + r) * DM) + lane; const v2u* ur = (const v2u*)(KV + (size_t)(m0 + r) * DM) + lane;
#pragma unroll
                for (int j = 0; j < 8; ++j) { v[r][j] = xr[64 * j]; uu[r][j] = ur[64 * j]; } }
#pragma unroll
            for (int r = 0; r < RB; ++r) {
                f32x4* xr = (f32x4*)(a.out + (size_t)(m0 + r) * DM) + lane;
                float s = 0.f;
#pragma unroll
                for (int j = 0; j < 8; ++j) { const f32x4 g2 = *(const f32x4*)(mod + 5 * DM + 4 * (lane + 64 * j)); const v2u w = uu[r][j];
                    v[r][j] = v[r][j] * ALPHA + g2 * (f32x4){bflo(w.x), bfhi(w.x), bflo(w.y), bfhi(w.y)};
                    s += (v[r][j].x + v[r][j].y) + (v[r][j].z + v[r][j].w); }
                const float mean = wave_sum(s) * (1.f / DM); float s2 = 0.f;
#pragma unroll
                for (int j = 0; j < 8; ++j) { v[r][j] = v[r][j] - mean; s2 += (v[r][j].x * v[r][j].x + v[r][j].y * v[r][j].y) + (v[r][j].z * v[r][j].z + v[r][j].w * v[r][j].w); }
                const float rstd = 1.f / sqrtf(wave_sum(s2) * (1.f / DM) + LN_EPS);
#pragma unroll
                for (int j = 0; j < 8; ++j) { const int col = 4 * (lane + 64 * j); const f32x4 gg = *(const f32x4*)(a.ln2_g + col), bb = *(const f32x4*)(a.ln2_b + col);
                    __builtin_nontemporal_store(v[r][j] * rstd * gg + bb, xr + 64 * j); }
            }
        }
    }
#undef IN
#undef SEAM
}

extern "C" void kernel_launch(void* const* d_in, const int* in_sizes, int n_in, void* d_out, int out_size, void* d_ws, size_t ws_size, hipStream_t stream) {
    static int grid = 0;
    if (grid == 0) {
        if (n_in != 22 || in_sizes[0] != M * DM || out_size != M * DM || ws_size < WS_END) {
            fprintf(stderr, "kernel_launch: unexpected shapes: n_in %d in0 %d out %d ws %zu (need >= %zu)\n", n_in, n_in > 0 ? in_sizes[0] : -1, out_size, ws_size, (size_t)WS_END); grid = -1; return; }
        int dev = 0, cus = 0, per_cu = 0;
        if (hipGetDevice(&dev) != hipSuccess || hipDeviceGetAttribute(&cus, hipDeviceAttributeMultiprocessorCount, dev) != hipSuccess) { grid = -1; return; }
        if (hipFuncSetAttribute((const void*)mk_fwd, hipFuncAttributeMaxDynamicSharedMemorySize, LDS_BYTES) != hipSuccess) { fprintf(stderr, "kernel_launch: hipFuncSetAttribute failed\n"); grid = -1; return; }
        if (hipOccupancyMaxActiveBlocksPerMultiprocessor(&per_cu, (const void*)mk_fwd, NWAVES * 64, LDS_BYTES) != hipSuccess || per_cu < 1) { fprintf(stderr, "kernel_launch: occupancy query gave %d\n", per_cu); per_cu = 1; }
        (void)hipGetLastError();
        grid = cus * 1;
    }
    if (grid < 0) return;
    (void)hipMemsetAsync(d_ws, 0, 2 * MiB, stream);
    Args a{};
    const float** f = (const float**)&a;
    for (int i = 0; i < 22; ++i) f[i] = (const float*)d_in[i];
    a.out = (float*)d_out; a.ws = (unsigned char*)d_ws;
#if MK_PER_PHASE
    for (int p = 0; p <= NPHASES; ++p) { a.ph_lo = p; a.ph_hi = p + 1; hipLaunchKernelGGL(mk_fwd, dim3(grid), dim3(NWAVES * 64), LDS_BYTES, stream, a); }
#else
    a.ph_lo = 0; a.ph_hi = NPHASES + 1;
    void* args[] = {&a};
    hipError_t e = hipLaunchCooperativeKernel((const void*)mk_fwd, dim3(grid), dim3(NWAVES * 64), args, LDS_BYTES, stream);
    if (e != hipSuccess) fprintf(stderr, "cooperative launch failed: %s (grid %d)\n", hipGetErrorString(e), grid);
#endif
}
```

```cpp
#include <hip/hip_runtime.h>
#include <hip/hip_cooperative_groups.h>
#include <hip/hip_bf16.h>
#include <cstdio>
#include <cstdint>
namespace cg = cooperative_groups;

#ifndef PROBE_P0
#define PROBE_P0 1
#endif
#ifndef PROBE_P1
#define PROBE_P1 1
#endif
#ifndef PROBE_GEMM
#define PROBE_GEMM 1
#endif
#ifndef PROBE_REP10
#define PROBE_REP10 1
#endif
#ifndef PROBE_REP6
#define PROBE_REP6 1
#endif
#ifndef MK_PER_PHASE
#define MK_PER_PHASE 0
#endif

constexpr int DM = 2048, NB = 4, SEQ = 8192, M = NB * SEQ;
constexpr int NPROJ = 6912;
constexpr int DFF = 5632;
constexpr float LN_EPS = 1e-5f, RMS_EPS = 1e-6f;
constexpr float ALPHA = 1.189207115002721f;
constexpr float CG_PRE = 0.088388347648318440f * 1.4426950408889634f;
constexpr float CM_PRE = 0.072168783648703220f * 1.4426950408889634f;
constexpr int PC_QG = 0, PC_KG = 1024, PC_VG = 1280, PC_QLAT = 1536, PC_KVLAT = 2048, PC_GATE = 2560, PC_KR = 6656;

constexpr size_t MiB = 1u << 20;
constexpr size_t WS_CTL = 0;
constexpr size_t WS_MOD = 65536;
constexpr size_t WS_TAB = 2 * MiB;
constexpr size_t WS_RINV = 3 * MiB;
constexpr size_t WS_WIN = 16 * MiB, WS_WUQ = 43 * MiB, WS_WUKV = 45 * MiB, WS_WBG = 47 * MiB, WS_WBM = 51 * MiB, WS_WOUT = 55 * MiB, WS_WGU = 63 * MiB, WS_WDN = 107 * MiB;
constexpr size_t WS_H = 130 * MiB;
constexpr size_t WS_PROJ = 258 * MiB;
constexpr size_t WS_KV = 690 * MiB;
constexpr size_t WS_YATT = 818 * MiB;
constexpr size_t WS_END = 946 * MiB;

__device__ __forceinline__ int mk_lane_id() { int l; asm volatile("v_mbcnt_lo_u32_b32 %0, -1, 0\n\tv_mbcnt_hi_u32_b32 %0, -1, %0" : "=&v"(l)); return l; }
namespace pg8 {
#define PG8_LAS __attribute__((address_space(3)))
typedef unsigned short bf16_t;
typedef short bf16x8 __attribute__((ext_vector_type(8)));
typedef float f32x4 __attribute__((ext_vector_type(4)));
typedef unsigned u32x4 __attribute__((ext_vector_type(4)));
constexpr int BM = 256, BK = 64, HALF = 128, HTB = HALF * BK * 2, STAGE_BYTES = 8 * HTB, NXCD = 8, WGM = 8;

__host__ __device__ __forceinline__ int lds_byte(int r, int c) { const int st = (r >> 4) * 2 + (c >> 5), rr = r & 15, cc = c & 31, ob = rr * 64 + cc * 2; return st * 1024 + (ob ^ (((ob >> 9) & 1) << 5)); }
__host__ __device__ __forceinline__ void stage_rc(int b, int& R, int& C) { const int st = b / 1024, sb = b % 1024, swz = sb ^ (((sb >> 9) & 1) << 5); R = (st >> 1) * 16 + swz / 64; C = (st & 1) * 32 + (swz % 64) / 2; }
__host__ __device__ __forceinline__ int perm32(int rho) { const int n = rho >> 4, i = rho & 15; return 8 * (i >> 2) + 4 * n + (i & 3); }

struct Unit { int pm, pn; };
struct Gemm { const bf16_t* A; const bf16_t* Bt; int lda; int Mr, N, K; };

struct StaticOrder {
    int nM, nN, nwg, G, c;
    __host__ __device__ void init(int Mr, int N, int G_, int c_) { nM = Mr / BM; nN = N / BM; nwg = nM * nN; G = G_; c = c_; }
    __host__ __device__ bool next(int i, Unit& u) const {
        const long L = (long)i * G + c; if (L >= nwg) return false;
        int wgid = (int)L; { const int q = nwg / NXCD, r = nwg % NXCD, xcd = wgid % NXCD, off = wgid / NXCD; wgid = (xcd < r ? xcd * (q + 1) : r * (q + 1) + (xcd - r) * q) + off; }
        const int nig = WGM * nN, gid = wgid / nig, fm = gid * WGM, gsz = (nM - fm) < WGM ? (nM - fm) : WGM;
        u.pm = fm + ((wgid % nig) % gsz); u.pn = (wgid % nig) / gsz; return true;
    }
};

__device__ __forceinline__ unsigned cvt_pk_bf16(float lo, float hi) { unsigned r; asm volatile("v_cvt_pk_bf16_f32 %0, %1, %2" : "=v"(r) : "v"(lo), "v"(hi)); return r; }
__device__ __forceinline__ float bf_lo(unsigned w) { return __uint_as_float(w << 16); }
__device__ __forceinline__ float bf_hi(unsigned w) { return __uint_as_float(w & 0xffff0000u); }
__device__ __forceinline__ float sigm(float v) { return __builtin_amdgcn_rcpf(1.f + __builtin_amdgcn_exp2f(-1.4426950408889634f * v)); }

struct EpiInProj {
    static constexpr bool PERM = true, MID = false;
    bf16_t* O; int ldc; const float* bg;
    __device__ __forceinline__ void operator()(const f32x4 (&acc)[2][2][4][2], const Unit& u, int wr, int wc, int fr, int fq) const {
        const int row0 = u.pm * BM + wr * 64 + fr, col0 = u.pn * BM + wc * 32 + 8 * fq;
        const bool isg = (u.pn >= 10 && u.pn < 26);
        f32x4 bv[2][2];
#pragma unroll
        for (int bj = 0; bj < 2; ++bj)
#pragma unroll
            for (int n = 0; n < 2; ++n) bv[bj][n] = isg ? *(const f32x4*)(bg + (col0 - PC_GATE) + bj * HALF + 4 * n) : (f32x4){0.f, 0.f, 0.f, 0.f};
#pragma unroll
        for (int ai = 0; ai < 2; ++ai)
#pragma unroll
            for (int m = 0; m < 4; ++m) { bf16_t* rowp = O + (size_t)(row0 + ai * HALF + m * 16) * ldc + col0;
#pragma unroll
                for (int bj = 0; bj < 2; ++bj) { f32x4 v0 = acc[ai][bj][m][0] + bv[bj][0], v1 = acc[ai][bj][m][1] + bv[bj][1];
                    if (isg) {
#pragma unroll
                        for (int j = 0; j < 4; ++j) { v0[j] = sigm(v0[j]); v1[j] = sigm(v1[j]); } }
                    u32x4 w; w.x = cvt_pk_bf16(v0[0], v0[1]); w.y = cvt_pk_bf16(v0[2], v0[3]); w.z = cvt_pk_bf16(v1[0], v1[1]); w.w = cvt_pk_bf16(v1[2], v1[3]);
                    *(u32x4*)(rowp + bj * HALF) = w; } }
    }
};
struct EpiRowScale {
    static constexpr bool PERM = true, MID = false;
    bf16_t* O; int ldc; const float* rs; float mul;
    __device__ __forceinline__ void operator()(const f32x4 (&acc)[2][2][4][2], const Unit& u, int wr, int wc, int fr, int fq) const {
        const int row0 = u.pm * BM + wr * 64 + fr, col0 = u.pn * BM + wc * 32 + 8 * fq;
#pragma unroll
        for (int ai = 0; ai < 2; ++ai)
#pragma unroll
            for (int m = 0; m < 4; ++m) { const int row = row0 + ai * HALF + m * 16; const float sc = (rs ? rs[row] : 1.f) * mul; bf16_t* rowp = O + (size_t)row * ldc + col0;
#pragma unroll
                for (int bj = 0; bj < 2; ++bj) { f32x4 v0 = acc[ai][bj][m][0] * sc, v1 = acc[ai][bj][m][1] * sc;
                    u32x4 w; w.x = cvt_pk_bf16(v0[0], v0[1]); w.y = cvt_pk_bf16(v0[2], v0[3]); w.z = cvt_pk_bf16(v1[0], v1[1]); w.w = cvt_pk_bf16(v1[2], v1[3]);
                    *(u32x4*)(rowp + bj * HALF) = w; } }
    }
};
struct EpiQM {
    static constexpr bool PERM = true, MID = false;
    bf16_t* O; int ldc; const float* rs; float mul; const float* CM; const float* SM; unsigned* nrm;
    __device__ __forceinline__ void operator()(const f32x4 (&acc)[2][2][4][2], const Unit& u, int wr, int wc, int fr, int fq) const {
        const int row0 = u.pm * BM + wr * 64 + fr, col0 = u.pn * BM + wc * 32 + 8 * fq;
        int ropef[2];
#pragma unroll
        for (int bj = 0; bj < 2; ++bj) { const int c0 = col0 + bj * HALF, within = c0 % 192; ropef[bj] = (within >= 128) ? ((within - 128) >> 1) : -1; }
        float pmx = 0.f;
#pragma unroll
        for (int ai = 0; ai < 2; ++ai)
#pragma unroll
            for (int m = 0; m < 4; ++m) { const int row = row0 + ai * HALF + m * 16; const float sc = rs[row] * mul; bf16_t* rowp = O + (size_t)row * ldc + col0;
                const int tp = row & 8191, prow = tp >> 6, pcol = tp & 63;
#pragma unroll
                for (int bj = 0; bj < 2; ++bj) { f32x4 v0 = acc[ai][bj][m][0] * sc, v1 = acc[ai][bj][m][1] * sc;
                    if (ropef[bj] >= 0) { const int i0 = ropef[bj], pos = (i0 < 16) ? prow : pcol, f0 = i0 & 15;
                        const f32x4 cs = *(const f32x4*)(CM + pos * 16 + f0), sn = *(const f32x4*)(SM + pos * 16 + f0);
                        const f32x4 a0 = v0, a1 = v1;
                        v0[0] = a0[0] * cs[0] - a0[1] * sn[0]; v0[1] = a0[0] * sn[0] + a0[1] * cs[0]; v0[2] = a0[2] * cs[1] - a0[3] * sn[1]; v0[3] = a0[2] * sn[1] + a0[3] * cs[1];
                        v1[0] = a1[0] * cs[2] - a1[1] * sn[2]; v1[1] = a1[0] * sn[2] + a1[1] * cs[2]; v1[2] = a1[2] * cs[3] - a1[3] * sn[3]; v1[3] = a1[2] * sn[3] + a1[3] * cs[3]; }
                    float q = (v0[0] * v0[0] + v0[1] * v0[1]) + (v0[2] * v0[2] + v0[3] * v0[3]) + (v1[0] * v1[0] + v1[1] * v1[1]) + (v1[2] * v1[2] + v1[3] * v1[3]);
                    q += __shfl_xor(q, 16); q += __shfl_xor(q, 32); pmx = fmaxf(pmx, q);
                    u32x4 w; w.x = cvt_pk_bf16(v0[0], v0[1]); w.y = cvt_pk_bf16(v0[2], v0[3]); w.z = cvt_pk_bf16(v1[0], v1[1]); w.w = cvt_pk_bf16(v1[2], v1[3]);
                    *(u32x4*)(rowp + bj * HALF) = w; } }
#pragma unroll
        for (int o = 1; o < 16; o <<= 1) pmx = fmaxf(pmx, __shfl_xor(pmx, o));
        if ((fr | fq) == 0) atomicMax(nrm, __float_as_uint(pmx * 1.02f));
    }
};
struct EpiKVNorm {
    static constexpr bool PERM = true, MID = false;
    bf16_t* O; int ldc; const float* rs; unsigned* nrm;
    __device__ __forceinline__ void operator()(const f32x4 (&acc)[2][2][4][2], const Unit& u, int wr, int wc, int fr, int fq) const {
        const int row0 = u.pm * BM + wr * 64 + fr, col0 = u.pn * BM + wc * 32 + 8 * fq;
        float pmx = 0.f;
#pragma unroll
        for (int ai = 0; ai < 2; ++ai)
#pragma unroll
            for (int m = 0; m < 4; ++m) { const int row = row0 + ai * HALF + m * 16; const float sc = rs[row]; bf16_t* rowp = O + (size_t)row * ldc + col0;
#pragma unroll
                for (int bj = 0; bj < 2; ++bj) { f32x4 v0 = acc[ai][bj][m][0] * sc, v1 = acc[ai][bj][m][1] * sc;
                    if (bj == 0) { float q = (v0[0] * v0[0] + v0[1] * v0[1]) + (v0[2] * v0[2] + v0[3] * v0[3]) + (v1[0] * v1[0] + v1[1] * v1[1]) + (v1[2] * v1[2] + v1[3] * v1[3]);
                        q += __shfl_xor(q, 16); q += __shfl_xor(q, 32); pmx = fmaxf(pmx, q); }
                    u32x4 w; w.x = cvt_pk_bf16(v0[0], v0[1]); w.y = cvt_pk_bf16(v0[2], v0[3]); w.z = cvt_pk_bf16(v1[0], v1[1]); w.w = cvt_pk_bf16(v1[2], v1[3]);
                    *(u32x4*)(rowp + bj * HALF) = w; } }
#pragma unroll
        for (int o = 1; o < 16; o <<= 1) pmx = fmaxf(pmx, __shfl_xor(pmx, o));
        if ((fr | fq) == 0) atomicMax(nrm, __float_as_uint(pmx * 1.02f));
    }
};
template <bool ADD> struct EpiGate {
    static constexpr bool PERM = true, MID = false;
    bf16_t* O; int ldc; const bf16_t* Gt; int ldg; const bf16_t* T; int ldt;
    __device__ __forceinline__ void operator()(const f32x4 (&acc)[2][2][4][2], const Unit& u, int wr, int wc, int fr, int fq) const {
        const int row0 = u.pm * BM + wr * 64 + fr, col0 = u.pn * BM + wc * 32 + 8 * fq;
#pragma unroll
        for (int ai = 0; ai < 2; ++ai)
#pragma unroll
            for (int m = 0; m < 4; ++m) { const int row = row0 + ai * HALF + m * 16; bf16_t* rowp = O + (size_t)row * ldc + col0;
#pragma unroll
                for (int bj = 0; bj < 2; ++bj) {
                    const u32x4 g = *(const u32x4*)(Gt + (size_t)row * ldg + col0 + bj * HALF);
                    f32x4 v0 = acc[ai][bj][m][0], v1 = acc[ai][bj][m][1];
                    v0[0] *= bf_lo(g.x); v0[1] *= bf_hi(g.x); v0[2] *= bf_lo(g.y); v0[3] *= bf_hi(g.y);
                    v1[0] *= bf_lo(g.z); v1[1] *= bf_hi(g.z); v1[2] *= bf_lo(g.w); v1[3] *= bf_hi(g.w);
                    if (ADD) { const u32x4 t = *(const u32x4*)(T + (size_t)row * ldt + col0 + bj * HALF);
                        v0[0] += bf_lo(t.x); v0[1] += bf_hi(t.x); v0[2] += bf_lo(t.y); v0[3] += bf_hi(t.y);
                        v1[0] += bf_lo(t.z); v1[1] += bf_hi(t.z); v1[2] += bf_lo(t.w); v1[3] += bf_hi(t.w); }
                    u32x4 w; w.x = cvt_pk_bf16(v0[0], v0[1]); w.y = cvt_pk_bf16(v0[2], v0[3]); w.z = cvt_pk_bf16(v1[0], v1[1]); w.w = cvt_pk_bf16(v1[2], v1[3]);
                    *(u32x4*)(rowp + bj * HALF) = w; } }
    }
};
struct EpiGateMerge {
    static constexpr bool PERM = true, MID = true;
    bf16_t* O; int ldc; const bf16_t* G1; const bf16_t* G2; int ldg;
    __device__ __forceinline__ void mid(f32x4 (&acc)[2][2][4][2], const Unit& u, int wr, int wc, int fr, int fq) const {
        int row0 = u.pm * BM + wr * 64 + fr, col0 = u.pn * BM + wc * 32 + 8 * fq;
        asm volatile("" : "+v"(row0), "+v"(col0));
#pragma unroll
        for (int ai = 0; ai < 2; ++ai)
#pragma unroll
            for (int m = 0; m < 4; ++m) { const size_t ro = (size_t)(row0 + ai * HALF + m * 16) * ldg + col0;
#pragma unroll
                for (int bj = 0; bj < 2; ++bj) {
                    const u32x4 a = *(const u32x4*)(G1 + ro + bj * HALF), b = *(const u32x4*)(G2 + ro + bj * HALF);
                    f32x4& v0 = acc[ai][bj][m][0]; f32x4& v1 = acc[ai][bj][m][1];
#define PG8_RT(x, y) ((x) * __builtin_amdgcn_rcpf(fmaxf((y), 1e-6f)))
                    v0[0] *= PG8_RT(bf_lo(a.x), bf_lo(b.x)); v0[1] *= PG8_RT(bf_hi(a.x), bf_hi(b.x)); v0[2] *= PG8_RT(bf_lo(a.y), bf_lo(b.y)); v0[3] *= PG8_RT(bf_hi(a.y), bf_hi(b.y));
                    v1[0] *= PG8_RT(bf_lo(a.z), bf_lo(b.z)); v1[1] *= PG8_RT(bf_hi(a.z), bf_hi(b.z)); v1[2] *= PG8_RT(bf_lo(a.w), bf_lo(b.w)); v1[3] *= PG8_RT(bf_hi(a.w), bf_hi(b.w));
#undef PG8_RT
                }
                asm volatile("" ::: "memory"); }
    }
    __device__ __forceinline__ void operator()(const f32x4 (&acc)[2][2][4][2], const Unit& u, int wr, int wc, int fr, int fq) const {
        const int row0 = u.pm * BM + wr * 64 + fr, col0 = u.pn * BM + wc * 32 + 8 * fq;
#pragma unroll
        for (int ai = 0; ai < 2; ++ai)
#pragma unroll
            for (int m = 0; m < 4; ++m) { const int row = row0 + ai * HALF + m * 16; bf16_t* rowp = O + (size_t)row * ldc + col0;
#pragma unroll
                for (int bj = 0; bj < 2; ++bj) {
                    const u32x4 g = *(const u32x4*)(G2 + (size_t)row * ldg + col0 + bj * HALF);
                    f32x4 v0 = acc[ai][bj][m][0], v1 = acc[ai][bj][m][1];
                    v0[0] *= fmaxf(bf_lo(g.x), 1e-6f); v0[1] *= fmaxf(bf_hi(g.x), 1e-6f); v0[2] *= fmaxf(bf_lo(g.y), 1e-6f); v0[3] *= fmaxf(bf_hi(g.y), 1e-6f);
                    v1[0] *= fmaxf(bf_lo(g.z), 1e-6f); v1[1] *= fmaxf(bf_hi(g.z), 1e-6f); v1[2] *= fmaxf(bf_lo(g.w), 1e-6f); v1[3] *= fmaxf(bf_hi(g.w), 1e-6f);
                    u32x4 w; w.x = cvt_pk_bf16(v0[0], v0[1]); w.y = cvt_pk_bf16(v0[2], v0[3]); w.z = cvt_pk_bf16(v1[0], v1[1]); w.w = cvt_pk_bf16(v1[2], v1[3]);
                    *(u32x4*)(rowp + bj * HALF) = w; } }
    }
};
struct EpiResid {
    static constexpr bool PERM = false, MID = false;
    const float* base; float* out; const float* gm; int gstride;
    __device__ __forceinline__ void operator()(const f32x4 (&acc)[2][2][4][2], const Unit& u, int wr, int wc, int fr, int fq) const {
        const int col0 = u.pn * BM + wc * 32 + 4 * fq; const float* gp = gm + (size_t)(u.pm >> 5) * gstride + col0;
        f32x4 gv[2][2];
#pragma unroll
        for (int bj = 0; bj < 2; ++bj)
#pragma unroll
            for (int n = 0; n < 2; ++n) gv[bj][n] = *(const f32x4*)(gp + bj * HALF + n * 16);
#pragma unroll
        for (int ai = 0; ai < 2; ++ai)
#pragma unroll
            for (int m = 0; m < 4; ++m) { const size_t off = (size_t)(u.pm * BM + ai * HALF + wr * 64 + m * 16 + fr) * DM + col0;
#pragma unroll
                for (int bj = 0; bj < 2; ++bj)
#pragma unroll
                    for (int n = 0; n < 2; ++n) { const f32x4 bs = *(const f32x4*)(base + off + bj * HALF + n * 16);
                        *(f32x4*)(out + off + bj * HALF + n * 16) = bs * ALPHA + gv[bj][n] * acc[ai][bj][m][n]; } }
    }
};
struct EpiSwiGLU {
    static constexpr bool PERM = true, MID = false;
    bf16_t* O; int ldc;
    __device__ __forceinline__ void operator()(const f32x4 (&acc)[2][2][4][2], const Unit& u, int wr, int wc, int fr, int fq) const {
        const int row0 = u.pm * BM + wr * 64 + fr, col0 = u.pn * HALF + wc * 32 + 8 * fq;
#pragma unroll
        for (int ai = 0; ai < 2; ++ai)
#pragma unroll
            for (int m = 0; m < 4; ++m) { bf16_t* rowp = O + (size_t)(row0 + ai * HALF + m * 16) * ldc + col0;
                f32x4 v0, v1;
#pragma unroll
                for (int j = 0; j < 4; ++j) { const float g0 = acc[ai][0][m][0][j], g1 = acc[ai][0][m][1][j];
                    v0[j] = g0 * sigm(g0) * acc[ai][1][m][0][j]; v1[j] = g1 * sigm(g1) * acc[ai][1][m][1][j]; }
                u32x4 w; w.x = cvt_pk_bf16(v0[0], v0[1]); w.y = cvt_pk_bf16(v0[2], v0[3]); w.z = cvt_pk_bf16(v1[0], v1[1]); w.w = cvt_pk_bf16(v1[2], v1[3]);
                *(u32x4*)rowp = w; }
    }
};

template <class Epi>
__device__ __forceinline__ void gemm_phase(PG8_LAS unsigned char* lds, const Gemm g, const StaticOrder& S, const Epi& E, int wv) {
    int tid = wv * 64 + mk_lane_id(); asm volatile("" : "+v"(tid));
    const int wid = __builtin_amdgcn_readfirstlane(tid >> 6), lane = tid & 63, wr = wid >> 2, wc = wid & 3, fr = lane & 15, fq = lane >> 4;
    const int K = g.K, nt = K / BK, lda = g.lda;
    unsigned voffA[2], voffB[2];
#pragma unroll
    for (int i = 0; i < 2; ++i) { int R, C; stage_rc(tid * 16 + i * 8192, R, C); const int Rb = Epi::PERM ? ((R & ~31) + perm32(R & 31)) : R;
        voffA[i] = (unsigned)(R * lda + C) * 2u; voffB[i] = (unsigned)(Rb * K + C) * 2u; }
    const size_t kstep = (size_t)(BK * 2);
    const size_t hstepA = (size_t)HALF * lda * 2, hstepB = (size_t)HALF * K * 2;
    const size_t tstepA = 2 * hstepA, tstepB = 2 * hstepB;
    const unsigned ldsw = (unsigned)wid * 1024u;
    const int aoff = lds_byte(wr * 64 + fr, fq * 8), boff = lds_byte(wc * 32 + fr, fq * 8);
#define PG8_SA(b, h) (((b) * 2 + (h)) * HTB)
#define PG8_SB(b, h) ((4 + (b) * 2 + (h)) * HTB)
#define PG8_STAGE(bufoff, gbase, voff) do { _Pragma("unroll") for (int _i = 0; _i < 2; ++_i) \
        __builtin_amdgcn_global_load_lds((const unsigned*)((const char*)(gbase) + (voff)[_i]), (PG8_LAS unsigned*)(lds + (bufoff) + ldsw + _i * 8192), 16, 0, 0); } while (0)
#define PG8_LDA(dst, b, h) do { _Pragma("unroll") for (int m = 0; m < 4; ++m) _Pragma("unroll") for (int k = 0; k < 2; ++k) dst[m][k] = *(const PG8_LAS bf16x8*)(lds + PG8_SA(b, h) + aoff + m * 2048 + k * 1024); } while (0)
#define PG8_LDB(dst, b, h) do { _Pragma("unroll") for (int n = 0; n < 2; ++n) _Pragma("unroll") for (int k = 0; k < 2; ++k) dst[n][k] = *(const PG8_LAS bf16x8*)(lds + PG8_SB(b, h) + boff + n * 2048 + k * 1024); } while (0)
#define PG8_MMA(ai, bj, At, Bt) do { __builtin_amdgcn_s_setprio(1); _Pragma("unroll") for (int m = 0; m < 4; ++m) _Pragma("unroll") for (int n = 0; n < 2; ++n) _Pragma("unroll") for (int k = 0; k < 2; ++k) \
        acc[ai][bj][m][n] = __builtin_amdgcn_mfma_f32_16x16x32_bf16(Bt[n][k], At[m][k], acc[ai][bj][m][n], 0, 0, 0); __builtin_amdgcn_s_setprio(0); } while (0)
#define PG8_WAIT_V(n) asm volatile("s_waitcnt vmcnt(" #n ")" ::: "memory")
#define PG8_WAIT_L(n) asm volatile("s_waitcnt lgkmcnt(" #n ")" ::: "memory")
#define PG8_BAR __builtin_amdgcn_s_barrier()
#define PG8_SCHED __builtin_amdgcn_sched_barrier(0)
    Unit cur, nxt; int ui = 0;
    if (!S.next(0, cur)) return;
    f32x4 acc[2][2][4][2];
#pragma unroll
    for (int a = 0; a < 2; ++a)
#pragma unroll
        for (int b = 0; b < 2; ++b)
#pragma unroll
            for (int m = 0; m < 4; ++m)
#pragma unroll
                for (int n = 0; n < 2; ++n) acc[a][b][m][n] = (f32x4){0.f, 0.f, 0.f, 0.f};
    bf16x8 At[4][2], B0[2][2], B1[2][2];
    const char* cA = (const char*)g.A + (size_t)cur.pm * tstepA; const char* cB = (const char*)g.Bt + (size_t)cur.pn * tstepB;
    PG8_STAGE(PG8_SB(0, 0), cB, voffB); PG8_STAGE(PG8_SB(0, 1), cB + hstepB, voffB); PG8_STAGE(PG8_SA(0, 0), cA, voffA); PG8_STAGE(PG8_SA(0, 1), cA + hstepA, voffA);
    if (wr == 1) PG8_BAR;
    PG8_WAIT_V(2); PG8_BAR;
    PG8_STAGE(PG8_SB(1, 0), cB + kstep, voffB); PG8_STAGE(PG8_SA(1, 0), cA + kstep, voffA); PG8_STAGE(PG8_SB(1, 1), cB + hstepB + kstep, voffB);
    PG8_WAIT_V(6); PG8_BAR;
    for (;;) {
        const bool has_next = S.next(ui + 1, nxt);
        const char* nA = has_next ? (const char*)g.A + (size_t)nxt.pm * tstepA : cA; const char* nB = has_next ? (const char*)g.Bt + (size_t)nxt.pn * tstepB : cB;
        for (int t = 0; t < nt; t += 2) {
            if constexpr (Epi::MID) { if (t == (nt >> 1)) E.mid(acc, cur, wr, wc, fr, fq); }
            const bool last = (t == nt - 2);
            const char* a1 = cA + (size_t)(t + 1) * kstep;
            const char* a2 = last ? nA : cA + (size_t)(t + 2) * kstep; const char* b2 = last ? nB : cB + (size_t)(t + 2) * kstep;
            const char* a3 = a2 + kstep; const char* b3 = b2 + kstep;
            PG8_LDB(B0, 0, 0); PG8_LDB(B1, 0, 1); PG8_SCHED; PG8_LDA(At, 0, 0); PG8_STAGE(PG8_SA(1, 1), a1 + hstepA, voffA);
            PG8_WAIT_V(8); PG8_WAIT_L(0); PG8_BAR; PG8_MMA(0, 0, At, B0); PG8_MMA(0, 1, At, B1); PG8_BAR; PG8_SCHED;
            PG8_LDA(At, 0, 1); PG8_STAGE(PG8_SB(0, 0), b2, voffB); PG8_STAGE(PG8_SB(0, 1), b2 + hstepB, voffB); PG8_STAGE(PG8_SA(0, 0), a2, voffA);
            PG8_WAIT_V(8); PG8_WAIT_L(0); PG8_BAR; PG8_MMA(1, 0, At, B0); PG8_MMA(1, 1, At, B1); PG8_BAR; PG8_SCHED;
            PG8_LDB(B0, 1, 0); PG8_LDB(B1, 1, 1); PG8_SCHED; PG8_LDA(At, 1, 0); PG8_STAGE(PG8_SA(0, 1), a2 + hstepA, voffA);
            PG8_WAIT_V(8); PG8_WAIT_L(0); PG8_BAR; PG8_MMA(0, 0, At, B0); PG8_MMA(0, 1, At, B1); PG8_BAR; PG8_SCHED;
            PG8_LDA(At, 1, 1); PG8_STAGE(PG8_SB(1, 0), b3, voffB); PG8_STAGE(PG8_SB(1, 1), b3 + hstepB, voffB); PG8_STAGE(PG8_SA(1, 0), a3, voffA);
            PG8_WAIT_V(8); PG8_WAIT_L(0); PG8_BAR; PG8_MMA(1, 0, At, B0); PG8_MMA(1, 1, At, B1); PG8_BAR; PG8_SCHED;
        }
        if (wr == 0) PG8_BAR;
        E(acc, cur, wr, wc, fr, fq);
        if (!has_next) break;
#pragma unroll
        for (int a = 0; a < 2; ++a)
#pragma unroll
            for (int b = 0; b < 2; ++b)
#pragma unroll
                for (int m = 0; m < 4; ++m)
#pragma unroll
                    for (int n = 0; n < 2; ++n) acc[a][b][m][n] = (f32x4){0.f, 0.f, 0.f, 0.f};
        cur = nxt; cA = nA; cB = nB; ++ui;
        if (wr == 1) PG8_BAR;
    }
    PG8_WAIT_V(0);
    PG8_BAR;
#undef PG8_SA
#undef PG8_SB
#undef PG8_STAGE
#undef PG8_LDA
#undef PG8_LDB
#undef PG8_MMA
#undef PG8_WAIT_V
#undef PG8_WAIT_L
#undef PG8_BAR
#undef PG8_SCHED
}
}

namespace att {
using bf16 = unsigned short;
using bf16x8 = __attribute__((ext_vector_type(8))) short;
using s16x4  = __attribute__((ext_vector_type(4))) short;
using f32x16 = __attribute__((ext_vector_type(16))) float;
using u32x4  = __attribute__((ext_vector_type(4))) unsigned;
constexpr int DV = 128, NW = 8, QBLK = 32, KVBLK = 64;
constexpr float THR = 8.f;
#define SBAR() __builtin_amdgcn_sched_barrier(0)
__device__ __forceinline__ int crow(int r, int hi) { return (r & 3) + 8 * (r >> 2) + 4 * hi; }
__device__ __forceinline__ unsigned cvtpk(float lo, float hi) { unsigned r; asm volatile("v_cvt_pk_bf16_f32 %0, %1, %2" : "=v"(r) : "v"(lo), "v"(hi)); return r; }

template <int DQK> struct Cfg {
    static constexpr int KROWB = DQK * 2;
    static constexpr int SHM_K = KVBLK * KROWB, SHM_V = KVBLK * DV * 2;
    static constexpr int SHM_TOTAL = 2 * SHM_V + 2 * SHM_K + NW * 64 * 4;
    static constexpr float SCALE = (DQK == 128) ? 0.088388347648318440f : 0.072168783648703220f;
    static constexpr float C = SCALE * 1.4426950408889634f;
};
template <int DQK> __device__ __forceinline__ int kswz(int row, int colB) {
  if (DQK == 128 || colB < 256) return row * Cfg<DQK>::KROWB + (colB ^ ((row & 15) << 4));
  return row * Cfg<DQK>::KROWB + 256 + ((colB - 256) ^ (((row >> 1) & 7) << 4));
}

template <int DQK> __device__ __forceinline__ void partialSM(f32x16& p0, f32x16& p1, float& m_reg, float& mn, float& alpha) {
  constexpr float THR2 = THR * 1.4426950408889634f;
  float pmax = p0[0];
#pragma unroll
  for (int r = 1; r < 16; ++r) pmax = fmaxf(pmax, p0[r]);
#pragma unroll
  for (int r = 0; r < 16; ++r) pmax = fmaxf(pmax, p1[r]);
  { auto rr = __builtin_amdgcn_permlane32_swap(__float_as_uint(pmax), __float_as_uint(pmax), false, false);
    pmax = fmaxf(__uint_as_float(rr[0]), __uint_as_float(rr[1])); }
  if (__builtin_expect(__all(pmax - m_reg <= THR2), 1)) { mn = m_reg; alpha = 1.f; }
  else { mn = fmaxf(m_reg, pmax); alpha = __builtin_amdgcn_exp2f(m_reg - mn); m_reg = mn; }
#pragma unroll
  for (int r = 0; r < 16; ++r) p0[r] = p0[r] - mn;
#pragma unroll
  for (int r = 0; r < 16; ++r) p1[r] = p1[r] - mn;
#pragma unroll
  for (int r = 0; r < 16; ++r) p0[r] = __builtin_amdgcn_exp2f(p0[r]);
}
__device__ __forceinline__ void partialSM_fast(f32x16& p0) {
#pragma unroll
  for (int r = 0; r < 16; ++r) p0[r] = __builtin_amdgcn_exp2f(p0[r]);
}
__device__ __forceinline__ void finishSM(f32x16& p0, f32x16& p1, float alpha, float& l_reg, bf16x8& pa0, bf16x8& pa1, bf16x8& pa2, bf16x8& pa3) {
#pragma unroll
  for (int r = 0; r < 16; ++r) p1[r] = __builtin_amdgcn_exp2f(p1[r]);
  float ps = 0;
#pragma unroll
  for (int r = 0; r < 16; ++r) ps += p0[r];
#pragma unroll
  for (int r = 0; r < 16; ++r) ps += p1[r];
  { auto rr = __builtin_amdgcn_permlane32_swap(__float_as_uint(ps), __float_as_uint(ps), false, false);
    ps = __uint_as_float(rr[0]) + __uint_as_float(rr[1]); }
  l_reg = l_reg * alpha + ps;
#define PK4(P, BASE, OUT) do { unsigned a0 = cvtpk(P[BASE + 0], P[BASE + 1]), a1 = cvtpk(P[BASE + 2], P[BASE + 3]);   \
    unsigned b0 = cvtpk(P[BASE + 4], P[BASE + 5]), b1 = cvtpk(P[BASE + 6], P[BASE + 7]);                              \
    auto r0 = __builtin_amdgcn_permlane32_swap(a0, b0, false, false); auto r1 = __builtin_amdgcn_permlane32_swap(a1, b1, false, false); \
    u32x4 w = {r0[0], r1[0], r0[1], r1[1]}; OUT = *reinterpret_cast<bf16x8*>(&w); } while (0)
  PK4(p0, 0, pa0); PK4(p0, 8, pa1); PK4(p1, 0, pa2); PK4(p1, 8, pa3);
#undef PK4
}
template <int DQK, int QREG> __device__ __forceinline__ void qkt(f32x16& p0, f32x16& p1, const char* Ks, const bf16x8* qr, const char* ql, int r32, int hi) {
  p0 = f32x16{}; p1 = f32x16{};
  unsigned ql2 = (unsigned)(uintptr_t)ql; if (QREG < DQK / 16) asm volatile("" : "+v"(ql2));
  asm volatile("" : "+v"(r32));
#pragma unroll
  for (int d0 = 0; d0 < DQK / 16; ++d0) { int cb = (d0 * 16 + hi * 8) * 2;
    bf16x8 b0 = *reinterpret_cast<const bf16x8*>(Ks + kswz<DQK>(r32, cb));
    bf16x8 b1 = *reinterpret_cast<const bf16x8*>(Ks + kswz<DQK>(32 + r32, cb));
    bf16x8 q; if (d0 < QREG) q = qr[d0]; else q = *(const __attribute__((address_space(3))) bf16x8*)(ql2 + (d0 - QREG) * 32);
    p0 = __builtin_amdgcn_mfma_f32_32x32x16_bf16(b0, q, p0, 0, 0, 0);
    p1 = __builtin_amdgcn_mfma_f32_32x32x16_bf16(b1, q, p1, 0, 0, 0); }
}
__device__ __forceinline__ int v_st(int k, int c) { const int kk = (k & ~0xC) | ((k & 4) << 1) | ((k & 8) >> 1); return ((kk >> 3) * 4 + (c >> 5)) * 512 + ((kk & 7) * 32 + (c & 31)) * 2; }
__device__ __forceinline__ int v_rd_base(int lane) { return ((lane & 3) << 3) | (((lane >> 2) & 3) << 6) | (((lane >> 4) & 1) << 5) | (((lane >> 5) & 1) << 8); }
constexpr int v_rd_off(int d0, int ks, int half) { return d0 * 512 + ks * 4096 + half * 2048; }
template <int OFF> __device__ __forceinline__ s16x4 tr_read(int vb) {
  s16x4 r; asm volatile("ds_read_b64_tr_b16 %0, %1 offset:%2" : "=&v"(r) : "v"(vb), "i"(OFF) : "memory"); return r;
}
template <int D0> __device__ __forceinline__ void pv_one(f32x16& od, int vb, bf16x8 pa0, bf16x8 pa1, bf16x8 pa2, bf16x8 pa3) {
  const s16x4 l0 = tr_read<v_rd_off(D0, 0, 0)>(vb), h0 = tr_read<v_rd_off(D0, 0, 1)>(vb), l1 = tr_read<v_rd_off(D0, 1, 0)>(vb), h1 = tr_read<v_rd_off(D0, 1, 1)>(vb);
  const s16x4 l2 = tr_read<v_rd_off(D0, 2, 0)>(vb), h2 = tr_read<v_rd_off(D0, 2, 1)>(vb), l3 = tr_read<v_rd_off(D0, 3, 0)>(vb), h3 = tr_read<v_rd_off(D0, 3, 1)>(vb);
  asm volatile("s_waitcnt lgkmcnt(0)" ::: "memory"); SBAR();
#define PK(L, H) (bf16x8){L[0], L[1], L[2], L[3], H[0], H[1], H[2], H[3]}
  od = __builtin_amdgcn_mfma_f32_32x32x16_bf16(pa0, PK(l0, h0), od, 0, 0, 0);
  od = __builtin_amdgcn_mfma_f32_32x32x16_bf16(pa1, PK(l1, h1), od, 0, 0, 0);
  od = __builtin_amdgcn_mfma_f32_32x32x16_bf16(pa2, PK(l2, h2), od, 0, 0, 0);
  od = __builtin_amdgcn_mfma_f32_32x32x16_bf16(pa3, PK(l3, h3), od, 0, 0, 0);
#undef PK
}
__device__ __forceinline__ void pv_d0(f32x16* o, int vb, bf16x8 pa0, bf16x8 pa1, bf16x8 pa2, bf16x8 pa3) {
  pv_one<0>(o[0], vb, pa0, pa1, pa2, pa3); pv_one<1>(o[1], vb, pa0, pa1, pa2, pa3); pv_one<2>(o[2], vb, pa0, pa1, pa2, pa3); pv_one<3>(o[3], vb, pa0, pa1, pa2, pa3);
}

template <int DQK, int QREG, int SDEPTH, int LDQ, int LDK, int LDKR, int LDV, int LDO>
__device__ __forceinline__ void attn_unit(const bf16* __restrict__ Qb, const bf16* __restrict__ Kh, const bf16* __restrict__ Kr, const bf16* __restrict__ Vh,
                                          bf16* __restrict__ Ob, int seq, char* lds, int wv) {
  using CF = Cfg<DQK>;
  constexpr int SHM_V = CF::SHM_V, SHM_K = CF::SHM_K; constexpr bool ROPE = (DQK == 192);
  int tid = wv * 64 + mk_lane_id(); asm volatile("" : "+v"(tid));
  const int wid = tid >> 6, lane = tid & 63, r32 = lane & 31, hi = lane >> 5;
  char* V_lds = lds; char* K_lds = lds + 2 * SHM_V;
  float* ws = (float*)(lds + 2 * SHM_V + 2 * SHM_K) + wid * 64; float* li_l = ws; float* al_l = ws + 32;
  float m_reg = -1e30f, l_reg = 0; f32x16 o[4] = {}; bf16x8 qr[QREG];
  constexpr int QL = DQK / 16 - QREG, QSTR = QL * 32 + 16;
  char* ql = lds + 2 * SHM_V + 2 * SHM_K + NW * 64 * 4 + (wid * QBLK + r32) * QSTR + hi * 16;
  const bf16* Qw = Qb + (long)(wid * QBLK + r32) * LDQ + hi * 8;
#pragma unroll
  for (int d0 = 0; d0 < DQK / 16; ++d0) { const bf16x8 t = *reinterpret_cast<const bf16x8*>(Qw + d0 * 16); if (d0 < QREG) qr[d0] = t; else *reinterpret_cast<bf16x8*>(ql + (d0 - QREG) * 32) = t; }
  const int sr = tid >> 4, sc = (tid & 15) * 8, vst0 = v_st(sr, sc), vst1 = v_st(32 + sr, sc);
  const int rr_ = tid >> 3, rc_ = (tid & 7) * 8;
  const int vb0 = (int)(uintptr_t)V_lds + v_rd_base(lane);
  struct { bf16x8 vs0, vs1, ks0, ks1, kr; } sr_[SDEPTH];
#define SLOAD(i, k0) do { sr_[i].vs0 = *(const bf16x8*)(&Vh[(long)((k0) + sr) * LDV + sc]); sr_[i].vs1 = *(const bf16x8*)(&Vh[(long)((k0) + 32 + sr) * LDV + sc]); \
    sr_[i].ks0 = *(const bf16x8*)(&Kh[(long)((k0) + sr) * LDK + sc]); sr_[i].ks1 = *(const bf16x8*)(&Kh[(long)((k0) + 32 + sr) * LDK + sc]); \
    if constexpr (ROPE) sr_[i].kr = *(const bf16x8*)(&Kr[(long)((k0) + rr_) * LDKR + rc_]); } while (0)
#define SWRITE(b, i) do { *(bf16x8*)(V_lds + (b) * SHM_V + vst0) = sr_[i].vs0;          \
    *(bf16x8*)(V_lds + (b) * SHM_V + vst1) = sr_[i].vs1; int kc = sc * 2;               \
    *(bf16x8*)(K_lds + (b) * SHM_K + kswz<DQK>(sr, kc)) = sr_[i].ks0;                       \
    *(bf16x8*)(K_lds + (b) * SHM_K + kswz<DQK>(32 + sr, kc)) = sr_[i].ks1;                  \
    if constexpr (ROPE) *(bf16x8*)(K_lds + (b) * SHM_K + kswz<DQK>(rr_, 256 + rc_ * 2)) = sr_[i].kr; } while (0)
#define SWAIT() do { if constexpr (SDEPTH == 2) { if constexpr (ROPE) asm volatile("s_waitcnt vmcnt(5)" ::: "memory"); else asm volatile("s_waitcnt vmcnt(4)" ::: "memory"); } else asm volatile("s_waitcnt vmcnt(0)" ::: "memory"); } while (0)
#define RESC(a) do { if (__any((a) < 1.f)) { if (hi == 0) al_l[r32] = (a); asm volatile("s_waitcnt lgkmcnt(0)" ::: "memory"); \
    _Pragma("unroll") for (int d = 0; d < 4; ++d) _Pragma("unroll") for (int r = 0; r < 16; ++r) o[d][r] *= al_l[crow(r, hi)]; } } while (0)
  f32x16 pA0, pA1, pB0, pB1; float mnA, mnB, alA, alB; bf16x8 pa0, pa1, pa2, pa3; const int NT = seq / KVBLK;
  constexpr int SE = 0, SO = SDEPTH - 1;
  SLOAD(SE, 0); asm volatile("s_waitcnt vmcnt(0)" ::: "memory"); SWRITE(0, SE); __syncthreads();
  qkt<DQK, QREG>(pA0, pA1, K_lds, qr, ql, r32, hi); partialSM<DQK>(pA0, pA1, m_reg, mnA, alA);
  SLOAD(SO, KVBLK); if constexpr (SDEPTH == 2) { if (2 < NT) SLOAD(SE, 2 * KVBLK); }
  SWAIT(); SWRITE(1, SO); __syncthreads();
  for (int j = 1; j + 1 < NT; j += 2) {
    SBAR(); qkt<DQK, QREG>(pB0, pB1, K_lds + SHM_K, qr, ql, r32, hi);
    finishSM(pA0, pA1, alA, l_reg, pa0, pa1, pa2, pa3); SBAR();
    SLOAD(SO, (j + SDEPTH) * KVBLK); SBAR();
    pv_d0(o, vb0, pa0, pa1, pa2, pa3); partialSM<DQK>(pB0, pB1, m_reg, mnB, alB);
    __syncthreads(); SWAIT(); SWRITE(0, SE);
    RESC(alB); __syncthreads();
    SBAR(); qkt<DQK, QREG>(pA0, pA1, K_lds, qr, ql, r32, hi);
    finishSM(pB0, pB1, alB, l_reg, pa0, pa1, pa2, pa3); SBAR();
    if (SDEPTH == 1 || j + 3 < NT) SLOAD(SE, (j + 1 + SDEPTH) * KVBLK); SBAR();
    pv_d0(o, vb0 + (int)SHM_V, pa0, pa1, pa2, pa3); partialSM<DQK>(pA0, pA1, m_reg, mnA, alA);
    __syncthreads(); SWAIT(); SWRITE(1, SO);
    RESC(alA); __syncthreads();
  }
  SBAR(); qkt<DQK, QREG>(pB0, pB1, K_lds + SHM_K, qr, ql, r32, hi);
  finishSM(pA0, pA1, alA, l_reg, pa0, pa1, pa2, pa3); SBAR();
  pv_d0(o, vb0, pa0, pa1, pa2, pa3); partialSM<DQK>(pB0, pB1, m_reg, mnB, alB);
  __syncthreads(); RESC(alB);
  finishSM(pB0, pB1, alB, l_reg, pa0, pa1, pa2, pa3); SBAR();
  pv_d0(o, vb0 + (int)SHM_V, pa0, pa1, pa2, pa3);
  {
    int tid2 = wv * 64 + mk_lane_id(); asm volatile("" : "+v"(tid2));
    const int wid2 = tid2 >> 6, r32b = tid2 & 31, hib = (tid2 >> 5) & 1;
    float* li2 = (float*)(lds + 2 * SHM_V + 2 * SHM_K) + wid2 * 64;
    if (hib == 0) li2[r32b] = l_reg; asm volatile("s_waitcnt lgkmcnt(0)" ::: "memory");
    bf16* Ow = Ob + (long)(wid2 * QBLK) * LDO + r32b;
#pragma unroll
    for (int r = 0; r < 16; ++r) { const int orow = crow(r, hib); const float rl = __builtin_amdgcn_rcpf(li2[orow]);
#pragma unroll
      for (int d0 = 0; d0 < 4; ++d0) { const float v = o[d0][r] * rl; Ow[(long)orow * LDO + d0 * 32] = (bf16)(cvtpk(v, v) & 0xffffu); } }
  }
  __syncthreads();
#undef SLOAD
#undef SWRITE
#undef SWAIT
#undef RESC
}

template <int DQK, int QREG, int LDQ, int LDK, int LDKR, int LDV, int LDO>
__device__ __forceinline__ void attn_unit_dma(const bf16* __restrict__ Qb, const bf16* __restrict__ Kh, const bf16* __restrict__ Kr, const bf16* __restrict__ Vh,
                                              bf16* __restrict__ Ob, int seq, char* lds, __attribute__((address_space(3))) unsigned char* l3, const char* wsb) {
  using CF = Cfg<DQK>;
  constexpr int SHM_V = CF::SHM_V, SHM_K = CF::SHM_K; constexpr bool ROPE = (DQK == 192);
  constexpr int NKP = SHM_K / 8192;
  constexpr int OFF_K = 3 * SHM_V, OFF_WS = OFF_K + 3 * SHM_K, OFF_Q = OFF_WS + NW * 64 * 4;
  int tid = threadIdx.x; asm volatile("" : "+v"(tid));
  const int wid = tid >> 6, lane = tid & 63, r32 = lane & 31, hi = lane >> 5;
  const int wu = __builtin_amdgcn_readfirstlane(wid);
  char* V_lds = lds; char* K_lds = lds + OFF_K;
  float* ws = (float*)(lds + OFF_WS) + wid * 64; float* li_l = ws; float* al_l = ws + 32;
  unsigned koff[NKP], kstr[NKP], voff[2];
#pragma unroll
  for (int i = 0; i < NKP; ++i) { const int p = (wid + 8 * i) * 64 + lane;
    if constexpr (!ROPE) { const int row = p >> 4, ch = (p & 15) ^ (row & 15); koff[i] = (unsigned)((const char*)Kh - wsb) + (unsigned)(row * LDK + ch * 8) * 2u; kstr[i] = 64u * LDK * 2u; }
    else { const int row = p / 24, chp = p - row * 24;
      if (chp < 16) { koff[i] = (unsigned)((const char*)Kh - wsb) + (unsigned)(row * LDK + ((chp ^ (row & 15)) * 8)) * 2u; kstr[i] = 64u * LDK * 2u; }
      else { koff[i] = (unsigned)((const char*)Kr - wsb) + (unsigned)(row * LDKR + (((chp - 16) ^ ((row >> 1) & 7)) * 8)) * 2u; kstr[i] = 64u * LDKR * 2u; } } }
#pragma unroll
  for (int i = 0; i < 2; ++i) { const int b = ((wid + 8 * i) * 64 + lane) * 16, st = b >> 9, wb = b & 511, kk = (st >> 2) * 8 + (wb >> 6), c = (st & 3) * 32 + ((wb & 63) >> 1);
    const int k = (kk & ~0xC) | ((kk & 4) << 1) | ((kk & 8) >> 1); voff[i] = (unsigned)((const char*)Vh - wsb) + (unsigned)(k * LDV + c) * 2u; }
#define DMA_K(slotoff) do { _Pragma("unroll") for (int i_ = 0; i_ < NKP; ++i_) \
    __builtin_amdgcn_global_load_lds((const unsigned*)(wsb + koff[i_]), (__attribute__((address_space(3))) unsigned*)(l3 + OFF_K + (slotoff) + (wu + 8 * i_) * 1024), 16, 0, 0); } while (0)
#define DMA_V(slotoff) do { _Pragma("unroll") for (int i_ = 0; i_ < 2; ++i_) \
    __builtin_amdgcn_global_load_lds((const unsigned*)(wsb + voff[i_]), (__attribute__((address_space(3))) unsigned*)(l3 + (slotoff) + (wu + 8 * i_) * 1024), 16, 0, 0); } while (0)
#define ADV_K() do { _Pragma("unroll") for (int i_ = 0; i_ < NKP; ++i_) koff[i_] += kstr[i_]; } while (0)
#define ADV_V() do { voff[0] += 64u * LDV * 2u; voff[1] += 64u * LDV * 2u; } while (0)
#define WAITBAR(N) asm volatile("s_waitcnt vmcnt(" #N ") lgkmcnt(0)\n\ts_barrier" ::: "memory")
  float m_reg = -1e30f, l_reg = 0; f32x16 o[4] = {}; bf16x8 qr[QREG];
  constexpr int QL = DQK / 16 - QREG, QSTR = QL * 32 + 16;
  char* ql = lds + OFF_Q + (wid * QBLK + r32) * QSTR + hi * 16;
  DMA_K(0); ADV_K(); DMA_V(0); ADV_V(); DMA_K(SHM_K); ADV_K();
  const bf16* Qw = Qb + (long)(wid * QBLK + r32) * LDQ + hi * 8;
#pragma unroll
  for (int d0 = 0; d0 < DQK / 16; ++d0) { const bf16x8 t = *reinterpret_cast<const bf16x8*>(Qw + d0 * 16); if (d0 < QREG) qr[d0] = t; else *reinterpret_cast<bf16x8*>(ql + (d0 - QREG) * 32) = t; }
  const int vb0 = (int)(uintptr_t)V_lds + v_rd_base(lane);
#define RESC(a) do { if (__any((a) < 1.f)) { if (hi == 0) al_l[r32] = (a); asm volatile("s_waitcnt lgkmcnt(0)" ::: "memory"); \
    _Pragma("unroll") for (int d = 0; d < 4; ++d) _Pragma("unroll") for (int r = 0; r < 16; ++r) o[d][r] *= al_l[crow(r, hi)]; } } while (0)
  f32x16 pA0, pA1, pB0, pB1; float mnA, mnB, alA, alB; bf16x8 pa0, pa1, pa2, pa3; const int NT = seq / KVBLK;
  WAITBAR(0);
  int ks_cur = 0, ks_nxt = SHM_K, ks_prv = 2 * SHM_K;
  int vs_prv = 2 * SHM_V, vs_cur = 0, vs_nxt = SHM_V;
#define ROTK() do { const int t_ = ks_cur; ks_cur = ks_nxt; ks_nxt = ks_prv; ks_prv = t_; } while (0)
#define ROTV() do { const int t_ = vs_prv; vs_prv = vs_cur; vs_cur = vs_nxt; vs_nxt = t_; } while (0)
  DMA_K(__builtin_amdgcn_readfirstlane(ks_prv)); ADV_K(); DMA_V(__builtin_amdgcn_readfirstlane(vs_nxt)); ADV_V();
  qkt<DQK, QREG>(pA0, pA1, K_lds + ks_cur, qr, ql, r32, hi); partialSM<DQK>(pA0, pA1, m_reg, mnA, alA);
  if constexpr (ROPE) WAITBAR(5); else WAITBAR(4);
  ROTK(); ROTV();
#define STEP(PN0, PN1, PO0, PO1, MN, ALN, ALO) do { \
    DMA_K(__builtin_amdgcn_readfirstlane(ks_prv)); ADV_K(); DMA_V(__builtin_amdgcn_readfirstlane(vs_nxt)); ADV_V(); \
    SBAR(); qkt<DQK, QREG>(PN0, PN1, K_lds + ks_cur, qr, ql, r32, hi); \
    finishSM(PO0, PO1, ALO, l_reg, pa0, pa1, pa2, pa3); SBAR(); \
    pv_d0(o, vb0 + vs_prv, pa0, pa1, pa2, pa3); partialSM<DQK>(PN0, PN1, m_reg, MN, ALN); \
    RESC(ALN); \
    if constexpr (ROPE) WAITBAR(5); else WAITBAR(4); \
    ROTK(); ROTV(); } while (0)
  for (int j = 1; j + 1 < NT; j += 2) {
    STEP(pB0, pB1, pA0, pA1, mnB, alB, alA);
    STEP(pA0, pA1, pB0, pB1, mnA, alA, alB);
  }
  STEP(pB0, pB1, pA0, pA1, mnB, alB, alA);
  finishSM(pB0, pB1, alB, l_reg, pa0, pa1, pa2, pa3); SBAR();
  pv_d0(o, vb0 + vs_prv, pa0, pa1, pa2, pa3);
  if (hi == 0) li_l[r32] = l_reg; asm volatile("s_waitcnt lgkmcnt(0)" ::: "memory");
  float rli[16];
#pragma unroll
  for (int r = 0; r < 16; ++r) rli[r] = __builtin_amdgcn_rcpf(li_l[crow(r, hi)]);
  bf16* Ow = Ob + (long)(wid * QBLK) * LDO;
#pragma unroll
  for (int r = 0; r < 16; ++r) { int orow = crow(r, hi);
#pragma unroll
    for (int d0 = 0; d0 < 4; ++d0) { const float v = o[d0][r] * rli[r]; Ow[(long)orow * LDO + d0 * 32 + r32] = (bf16)(cvtpk(v, v) & 0xffffu); } }
  WAITBAR(0);
#undef DMA_K
#undef DMA_V
#undef ADV_K
#undef ADV_V
#undef WAITBAR
#undef RESC
#undef ROTK
#undef ROTV
#undef STEP
}
template <int DQK, int QREG, bool FAST, int LDQ, int LDK, int LDKR, int LDV, int LDO>
__device__ __forceinline__ void attn_unit_stag(const bf16* __restrict__ Qb, const bf16* __restrict__ Kh, const bf16* __restrict__ Kr, const bf16* __restrict__ Vh,
                                              bf16* __restrict__ Ob, int seq, char* lds, __attribute__((address_space(3))) unsigned char* l3, const char* wsb, int wv) {
  using CF = Cfg<DQK>;
  constexpr int SHM_V = CF::SHM_V, SHM_K = CF::SHM_K; constexpr bool ROPE = (DQK == 192);
  constexpr int NKP = SHM_K / 8192;
  constexpr int OFF_K = 3 * SHM_V, OFF_WS = OFF_K + 3 * SHM_K, OFF_Q = OFF_WS + NW * 64 * 4;
  int tid = wv * 64 + mk_lane_id(); asm volatile("" : "+v"(tid));
  const int wid = tid >> 6, lane = tid & 63, r32 = lane & 31, hi = lane >> 5;
  const int wu = __builtin_amdgcn_readfirstlane(wid);
  char* V_lds = lds; char* K_lds = lds + OFF_K;
  float* ws = (float*)(lds + OFF_WS) + wid * 64; float* li_l = ws; float* al_l = ws + 32;
  unsigned koff[NKP], voff[2]; bool kn[NKP];
#pragma unroll
  for (int i = 0; i < NKP; ++i) { const int p = (wid + 8 * i) * 64 + lane;
    if constexpr (!ROPE) { const int row = p >> 4, ch = (p & 15) ^ (row & 15); koff[i] = (unsigned)((const char*)Kh - wsb) + (unsigned)(row * LDK + ch * 8) * 2u; kn[i] = true; }
    else { const int row = p / 24, chp = p - row * 24;
      kn[i] = chp < 16;
      if (chp < 16) { koff[i] = (unsigned)((const char*)Kh - wsb) + (unsigned)(row * LDK + ((chp ^ (row & 15)) * 8)) * 2u; }
      else { koff[i] = (unsigned)((const char*)Kr - wsb) + (unsigned)(row * LDKR + (((chp - 16) ^ ((row >> 1) & 7)) * 8)) * 2u; } } }
#pragma unroll
  for (int i = 0; i < 2; ++i) { const int b = ((wid + 8 * i) * 64 + lane) * 16, st = b >> 9, wb = b & 511, kk = (st >> 2) * 8 + (wb >> 6), c = (st & 3) * 32 + ((wb & 63) >> 1);
    const int k = (kk & ~0xC) | ((kk & 4) << 1) | ((kk & 8) >> 1); voff[i] = (unsigned)((const char*)Vh - wsb) + (unsigned)(k * LDV + c) * 2u; }
#define DMA_K(slotoff) do { _Pragma("unroll") for (int i_ = 0; i_ < NKP; ++i_) \
    __builtin_amdgcn_global_load_lds((const unsigned*)(wsb + koff[i_]), (__attribute__((address_space(3))) unsigned*)(l3 + OFF_K + (slotoff) + (wu + 8 * i_) * 1024), 16, 0, 0); } while (0)
#define DMA_V(slotoff) do { _Pragma("unroll") for (int i_ = 0; i_ < 2; ++i_) \
    __builtin_amdgcn_global_load_lds((const unsigned*)(wsb + voff[i_]), (__attribute__((address_space(3))) unsigned*)(l3 + (slotoff) + (wu + 8 * i_) * 1024), 16, 0, 0); } while (0)
#define ADV_K() do { _Pragma("unroll") for (int i_ = 0; i_ < NKP; ++i_) koff[i_] += (!ROPE || kn[i_]) ? 64u * LDK * 2u : 64u * LDKR * 2u; } while (0)
#define ADV_V() do { voff[0] += 64u * LDV * 2u; voff[1] += 64u * LDV * 2u; } while (0)
#define WAITBAR(N) asm volatile("s_waitcnt vmcnt(" #N ") lgkmcnt(0)\n\ts_barrier" ::: "memory")
  float m_reg = -1e30f, l_reg = 0; f32x16 o[4] = {}; bf16x8 qr[QREG];
  constexpr int QL = DQK / 16 - QREG, QSTR = QL * 32 + 16;
  char* ql = lds + OFF_Q + (wid * QBLK + r32) * QSTR + hi * 16;
  DMA_K(0); ADV_K(); DMA_V(0); ADV_V(); DMA_K(SHM_K); ADV_K();
  const bf16* Qw = Qb + (long)(wid * QBLK + r32) * LDQ + hi * 8;
#pragma unroll
  for (int d0 = 0; d0 < DQK / 16; ++d0) { const bf16x8 t = *reinterpret_cast<const bf16x8*>(Qw + d0 * 16); if (d0 < QREG) qr[d0] = t; else *reinterpret_cast<bf16x8*>(ql + (d0 - QREG) * 32) = t; }
  const int vb0 = (int)(uintptr_t)V_lds + v_rd_base(lane);
#define RESC(a) do { if (__any((a) < 1.f)) { if (hi == 0) al_l[r32] = (a); asm volatile("s_waitcnt lgkmcnt(0)" ::: "memory"); \
    _Pragma("unroll") for (int d = 0; d < 4; ++d) _Pragma("unroll") for (int r = 0; r < 16; ++r) o[d][r] *= al_l[crow(r, hi)]; } } while (0)
  f32x16 pA0, pA1, pB0, pB1; float mnA, mnB, alA, alB; bf16x8 pa0, pa1, pa2, pa3; const int NT = seq / KVBLK;
  WAITBAR(0);
  int ks_cur = 0, ks_nxt = SHM_K, ks_prv = 2 * SHM_K;
  int vs_prv = 2 * SHM_V, vs_cur = 0, vs_nxt = SHM_V;
#define ROTK() do { const int t_ = ks_cur; ks_cur = ks_nxt; ks_nxt = ks_prv; ks_prv = t_; } while (0)
#define ROTV() do { const int t_ = vs_prv; vs_prv = vs_cur; vs_cur = vs_nxt; vs_nxt = t_; } while (0)
  DMA_K(__builtin_amdgcn_readfirstlane(ks_prv)); ADV_K(); DMA_V(__builtin_amdgcn_readfirstlane(vs_nxt)); ADV_V();
  qkt<DQK, QREG>(pA0, pA1, K_lds + ks_cur, qr, ql, r32, hi);
  if constexpr (FAST) { partialSM_fast(pA0); alA = 1.f; } else partialSM<DQK>(pA0, pA1, m_reg, mnA, alA);
  if constexpr (ROPE) WAITBAR(5); else WAITBAR(4);
  ROTK(); ROTV();
#define WB() do { if constexpr (ROPE) WAITBAR(5); else WAITBAR(4); } while (0)
#define H1(PN0, PN1, PO0, PO1, ALO) do { \
    DMA_K(__builtin_amdgcn_readfirstlane(ks_prv)); ADV_K(); \
    SBAR(); qkt<DQK, QREG>(PN0, PN1, K_lds + ks_cur, qr, ql, r32, hi); \
    finishSM(PO0, PO1, ALO, l_reg, pa0, pa1, pa2, pa3); SBAR(); WB(); } while (0)
#define H2(PN0, PN1, MN, ALN) do { \
    DMA_V(__builtin_amdgcn_readfirstlane(vs_nxt)); ADV_V(); \
    SBAR(); pv_d0(o, vb0 + vs_prv, pa0, pa1, pa2, pa3); \
    if constexpr (FAST) { partialSM_fast(PN0); ALN = 1.f; } else { partialSM<DQK>(PN0, PN1, m_reg, MN, ALN); RESC(ALN); } \
    WB(); ROTK(); ROTV(); } while (0)
  const bool lag = wu >= 4;
  if (lag) WB();
  for (int j = 1; j + 1 < NT; j += 2) {
    H1(pB0, pB1, pA0, pA1, alA); H2(pB0, pB1, mnB, alB);
    H1(pA0, pA1, pB0, pB1, alB); H2(pA0, pA1, mnA, alA);
  }
  H1(pB0, pB1, pA0, pA1, alA); H2(pB0, pB1, mnB, alB);
  if (!lag) WB();
  finishSM(pB0, pB1, alB, l_reg, pa0, pa1, pa2, pa3); SBAR();
  pv_d0(o, vb0 + vs_prv, pa0, pa1, pa2, pa3);
  {
    int tid2 = wv * 64 + mk_lane_id(); asm volatile("" : "+v"(tid2));
    const int wid2 = tid2 >> 6, r32b = tid2 & 31, hib = (tid2 >> 5) & 1;
    float* li2 = (float*)(lds + OFF_WS) + wid2 * 64;
    if (hib == 0) li2[r32b] = l_reg; asm volatile("s_waitcnt lgkmcnt(0)" ::: "memory");
    bf16* Ow = Ob + (long)(wid2 * QBLK) * LDO + r32b;
#pragma unroll
    for (int r = 0; r < 16; ++r) { const int orow = crow(r, hib); const float rl = __builtin_amdgcn_rcpf(li2[orow]);
#pragma unroll
      for (int d0 = 0; d0 < 4; ++d0) { const float v = o[d0][r] * rl; Ow[(long)orow * LDO + d0 * 32] = (bf16)(cvtpk(v, v) & 0xffffu); } }
  }
  WAITBAR(0);
#undef DMA_K
#undef DMA_V
#undef ADV_K
#undef ADV_V
#undef WAITBAR
#undef RESC
#undef ROTK
#undef ROTV
#undef H1
#undef H2
#undef WB
}
#undef SBAR
}

#define LAS __attribute__((address_space(3)))
typedef unsigned short bf16;
typedef unsigned v4u __attribute__((ext_vector_type(4)));
typedef unsigned v2u __attribute__((ext_vector_type(2)));
typedef float f32x4 __attribute__((ext_vector_type(4)));
constexpr int NWAVES = 8;
constexpr int LDS_BYTES = 163840;
constexpr int NPHASES = 12;

__device__ __forceinline__ unsigned f2bf(float f) { unsigned u = __builtin_bit_cast(unsigned, f); return (u + 0x7fffu + ((u >> 16) & 1u)) >> 16; }
__device__ __forceinline__ unsigned pk2(float lo, float hi) { return f2bf(lo) | (f2bf(hi) << 16); }
__device__ __forceinline__ float bflo(unsigned w) { return __uint_as_float(w << 16); }
__device__ __forceinline__ float bfhi(unsigned w) { return __uint_as_float(w & 0xffff0000u); }
__device__ __forceinline__ float wave_sum(float v) {
#pragma unroll
    for (int o = 1; o < 64; o <<= 1) v += __shfl_xor(v, o);
    return v;
}


#define XB_TMO      128
#define XB_XCNT(j)  (256  + 64 * (j))
#define XB_XSUB(j)  (1280 + 64 * (j))
#define XB_XGEN(j)  (2304 + 64 * (j))
#define XB_TOP      3328
#define XB_TOPGEN   3392
#define XCD_BAR_WORDS 3456
#define XB_SPIN_CAP (1u << 18)
__device__ __forceinline__ unsigned xb_ld(unsigned* p)              { return __hip_atomic_load(p, __ATOMIC_RELAXED, __HIP_MEMORY_SCOPE_AGENT); }
__device__ __forceinline__ unsigned xb_add(unsigned* p, unsigned v) { return __hip_atomic_fetch_add(p, v, __ATOMIC_RELAXED, __HIP_MEMORY_SCOPE_AGENT); }
__device__ __forceinline__ unsigned xb_xcc_id() { return (unsigned)__builtin_amdgcn_s_getreg((3 << 11) | 20) & 0xFu; }
#define XB_SPIN(cond, bar) do { unsigned _sp = 0; while (cond) { __builtin_amdgcn_s_sleep(1); \
    if ((++_sp & 255u) == 0u) { if (xb_ld(&(bar)[XB_TMO])) break; if (_sp > XB_SPIN_CAP) { atomicAdd(&(bar)[XB_TMO], 1u); break; } } } } while (0)
struct XcdBarrier { unsigned* bar; unsigned x; volatile LAS unsigned* st; int wv; };
__device__ __forceinline__ XcdBarrier xcd_barrier_post(unsigned* bar, volatile LAS unsigned* st) {
    XcdBarrier b; b.bar = bar; b.x = xb_xcc_id(); b.st = st; b.wv = 0;
    if (threadIdx.x == 0) (void)xb_add(&bar[XB_XCNT(b.x)], 1u);
    return b;
}
__device__ __forceinline__ void xcd_barrier_complete(unsigned* bar, unsigned x, unsigned& nloc, unsigned& nx) {
    const unsigned G = gridDim.x * gridDim.y * gridDim.z;
    unsigned sum, cnt, mine, sp = 0u;
    for (;;) {
        sum = 0u; cnt = 0u; mine = 0u;
#pragma unroll
        for (unsigned j = 0; j < 16; ++j) { const unsigned c = xb_ld(&bar[XB_XCNT(j)]); sum += c; cnt += (c > 0u) ? 1u : 0u; mine = (j == x) ? c : mine; }
        if (sum == G) break;
        __builtin_amdgcn_s_sleep(1);
        if ((++sp & 255u) == 0u) { if (xb_ld(&bar[XB_TMO])) break; if (sp > XB_SPIN_CAP) { atomicAdd(&bar[XB_TMO], 1u); break; } }
    }
    nloc = mine > 0u ? mine : 1u; nx = cnt > 0u ? cnt : 1u;
}
__device__ __forceinline__ void xcd_barrier(const XcdBarrier& b) {
    asm volatile("s_waitcnt vmcnt(0)" ::: "memory");
    __syncthreads();
    if (b.wv == 0 && mk_lane_id() == 0) {
        unsigned* bar = b.bar;
        __builtin_amdgcn_s_waitcnt(0);
        unsigned nloc = b.st[0], nx = b.st[1];
        if (nloc == 0u) { xcd_barrier_complete(bar, b.x, nloc, nx); b.st[0] = nloc; b.st[1] = nx; }
        const unsigned old = xb_add(&bar[XB_XSUB(b.x)], 1u);
        const unsigned gen = old / nloc;
        if (old + 1u == (gen + 1u) * nloc) {
            __builtin_amdgcn_fence(__ATOMIC_RELEASE, "agent");
            asm volatile("s_waitcnt vmcnt(0)" ::: "memory");
            const unsigned og = xb_add(&bar[XB_TOP], 1u);
            const unsigned tg = og / nx;
            if (og + 1u == (tg + 1u) * nx) xb_add(&bar[XB_TOPGEN], 1u);
            else XB_SPIN(xb_ld(&bar[XB_TOPGEN]) == tg, bar);
            __builtin_amdgcn_fence(__ATOMIC_ACQUIRE, "agent");
            xb_add(&bar[XB_XGEN(b.x)], 1u);
            asm volatile("s_waitcnt vmcnt(0)" ::: "memory");
        } else {
            XB_SPIN(xb_ld(&bar[XB_XGEN(b.x)]) == gen, bar);
            __builtin_amdgcn_fence(__ATOMIC_ACQUIRE, "agent");
            asm volatile("s_waitcnt vmcnt(0)" ::: "memory");
        }
    }
    __syncthreads();
}

struct Args {
    const float* x; const float* c; const float* w_ada; const float* b_ada; const float* w_in; const float* b_gates;
    const float* gqa_q_gain; const float* gqa_k_gain; const float* mla_q_gain; const float* mla_kv_gain;
    const float* w_mla_uq; const float* w_mla_ukv; const float* w_branch_gqa; const float* w_branch_mla; const float* w_out;
    const float* ln1_g; const float* ln1_b; const float* w_ffn_gate; const float* w_ffn_up; const float* w_ffn_down; const float* ln2_g; const float* ln2_b;
    float* out; unsigned char* ws; int ph_lo, ph_hi;
};

__device__ __forceinline__ void tr_item(const float* W, int ldw, int k0, int sn0, bf16* WT, int ldt, int drow0, const float* ks, bool zero, LAS float* scr, int lane) {
    float t[32];
    const float* src = W + (size_t)(k0 + (lane >> 5)) * ldw + sn0 + (lane & 31);
#pragma unroll
    for (int i = 0; i < 32; ++i) t[i] = zero ? 0.f : __builtin_nontemporal_load(src + (size_t)(2 * i) * ldw);
    if (ks) {
#pragma unroll
        for (int i = 0; i < 32; ++i) t[i] *= ks[k0 + 2 * i + (lane >> 5)]; }
#pragma unroll
    for (int i = 0; i < 32; ++i) scr[(2 * i + (lane >> 5)) * 33 + (lane & 31)] = t[i];
    asm volatile("s_waitcnt lgkmcnt(0)" ::: "memory");
    const int c = lane & 7;
#pragma unroll
    for (int j = 0; j < 4; ++j) { const int n = (lane >> 3) + 8 * j; const LAS float* s = scr + (8 * c) * 33 + n;
        v4u o; o.x = pk2(s[0 * 33], s[1 * 33]); o.y = pk2(s[2 * 33], s[3 * 33]); o.z = pk2(s[4 * 33], s[5 * 33]); o.w = pk2(s[6 * 33], s[7 * 33]);
        *(v4u*)(WT + (size_t)(drow0 + n) * ldt + k0 + 8 * c) = o; }
    asm volatile("s_waitcnt lgkmcnt(0)" ::: "memory");
}

__global__ void __launch_bounds__(NWAVES * 64, 2) mk_fwd(Args a) {
    extern __shared__ __attribute__((aligned(16))) unsigned char lds[];
    cg::grid_group grid = cg::this_grid();
    const int tid = threadIdx.x;
    const int wave_s = __builtin_amdgcn_readfirstlane(tid >> 6);
    const int G = gridDim.x;
    const int NGW = G * NWAVES;
#define PHASE_IDS int tid_ = wave_s * 64 + mk_lane_id(); asm volatile("" : "+v"(tid_)); const int lane = tid_ & 63; const int wave = wave_s; const int gw = blockIdx.x * NWAVES + wave; (void)lane; (void)gw;
    unsigned char* ws = a.ws;
    float* MOD = (float*)(ws + WS_MOD);
    float* CGt = (float*)(ws + WS_TAB); float* SGt = CGt + 128 * 32; float* CMt = SGt + 128 * 32; float* SMt = CMt + 128 * 16;
    float* RINVQ = (float*)(ws + WS_RINV); float* RINVKV = RINVQ + M;
    unsigned* NRM = (unsigned*)(ws + WS_CTL) + 96;
    bf16* WIN = (bf16*)(ws + WS_WIN); bf16* WUQ = (bf16*)(ws + WS_WUQ); bf16* WUKV = (bf16*)(ws + WS_WUKV); bf16* WBG = (bf16*)(ws + WS_WBG); bf16* WBM = (bf16*)(ws + WS_WBM);
    bf16* WOUT = (bf16*)(ws + WS_WOUT); bf16* WGU = (bf16*)(ws + WS_WGU); bf16* WDN = (bf16*)(ws + WS_WDN);
    bf16* H = (bf16*)(ws + WS_H); bf16* QM = H; bf16* PROJ = (bf16*)(ws + WS_PROJ); bf16* ACT = PROJ; bf16* KV = (bf16*)(ws + WS_KV); bf16* T1 = KV; bf16* YATT = (bf16*)(ws + WS_YATT);
    const int lo = a.ph_lo, hi = a.ph_hi;
#ifndef PH_MASK
#define PH_MASK 0xffff
#endif
#define IN(k) (((PH_MASK >> (k)) & 1) && lo <= (k) && (k) < hi)
    volatile LAS unsigned* MISC = (volatile LAS unsigned*)((LAS unsigned char*)lds + LDS_BYTES - 128);
    if (tid < 32) MISC[tid] = 0u;
    __syncthreads();
    XcdBarrier bar = xcd_barrier_post((unsigned*)(ws + WS_CTL) + 4096, MISC + 8); bar.wv = wave_s;
    if (hi > 1000) grid.sync();
#define SEAM(k) do { if (lo <= (k) && (k) + 1 < hi) xcd_barrier(bar); } while (0)

    if (IN(0)) { PHASE_IDS
        LAS float* scr = (LAS float*)((LAS unsigned char*)lds + wave * 16384);
        constexpr int I_ADA = 48 * 32;
        constexpr int I_IN = 32 * 216, I_UQ = 8 * 48, I_UKV = 8 * 64, I_BG = 16 * 64, I_OUT = 32 * 64, I_G = 32 * 176, I_DN = 88 * 64;
        constexpr int NITEMS = I_ADA + I_IN + I_UQ + I_UKV + 2 * I_BG + I_OUT;
        (void)I_G; (void)I_DN;
        if (gw < 128) {
            const float pos = (float)gw;
            if (lane < 32) { const float f = powf(10000.f, -(float)lane / 32.f); const float ang = pos * f; CGt[gw * 32 + lane] = cosf(ang); SGt[gw * 32 + lane] = sinf(ang); }
            else if (lane < 48) { const int i = lane - 32; const float f = powf(10000.f, -(float)i / 16.f); const float ang = pos * f; CMt[gw * 16 + i] = cosf(ang); SMt[gw * 16 + i] = sinf(ang); }
        }
        for (int rep = 0; rep < PROBE_P0; ++rep)
        for (int it = gw + (rep ? ((I_ADA + NGW - 1) / NGW) * NGW : 0); it < NITEMS; it += NGW) {
            int r = it;
            if (r < I_ADA) {
                const int jc = r % 48, kc = r / 48, j0 = jc * 256 + lane * 4, k0 = kc * 64;
                float sb[4];
#pragma unroll
                for (int b = 0; b < 4; ++b) { const float cv = a.c[b * DM + k0 + lane]; sb[b] = cv / (1.f + __expf(-cv)); }
                f32x4 acc[4];
#pragma unroll
                for (int b = 0; b < 4; ++b) acc[b] = (f32x4){0.f, 0.f, 0.f, 0.f};
#pragma unroll 16
                for (int kk = 0; kk < 64; ++kk) { const f32x4 w = __builtin_nontemporal_load((const f32x4*)(a.w_ada + (size_t)(k0 + kk) * (6 * DM) + j0));
#pragma unroll
                    for (int b = 0; b < 4; ++b) { const float s = __shfl(sb[b], kk); acc[b] += w * s; } }
                if (kc == 0) { const f32x4 bb = *(const f32x4*)(a.b_ada + j0);
#pragma unroll
                    for (int b = 0; b < 4; ++b) acc[b] += bb; }
#pragma unroll
                for (int b = 0; b < 4; ++b)
#pragma unroll
                    for (int j = 0; j < 4; ++j) atomicAdd(MOD + b * (6 * DM) + j0 + j, acc[b][j]);
                continue; }
            r -= I_ADA;
            if (r < I_IN) { const int kb = r / 216, nb = r % 216, n0 = nb * 32; const bool z = n0 >= 6720; const int sn0 = n0 < 2560 ? n0 : (n0 < 6656 ? n0 + 64 : (z ? 0 : n0 - 6656 + 2560));
                tr_item(a.w_in, 6720, kb * 64, sn0, WIN, DM, n0, nullptr, z, scr, lane); continue; }
            r -= I_IN;
            if (r < I_UQ) { const int kb = r / 48, nb = r % 48; tr_item(a.w_mla_uq, 1536, kb * 64, nb * 32, WUQ, 512, nb * 32, a.mla_q_gain, false, scr, lane); continue; }
            r -= I_UQ;
            if (r < I_UKV) { const int kb = r / 64, nb = r % 64; tr_item(a.w_mla_ukv, 2048, kb * 64, nb * 32, WUKV, 512, nb * 32, a.mla_kv_gain, false, scr, lane); continue; }
            r -= I_UKV;
            if (r < I_BG) { const int kb = r / 64, nb = r % 64; tr_item(a.w_branch_gqa, DM, kb * 64, nb * 32, WBG, 2048, nb * 32, nullptr, false, scr, lane); continue; }
            r -= I_BG;
            if (r < I_BG) { const int kb = r / 64, nb = r % 64; tr_item(a.w_branch_mla, DM, kb * 64, nb * 32, WBG + 1024, 2048, nb * 32, nullptr, false, scr, lane); continue; }
            r -= I_BG;
            { const int kb = r / 64, nb = r % 64; tr_item(a.w_out, DM, kb * 64, nb * 32, WOUT, DM, nb * 32, nullptr, false, scr, lane); }
        }
    }
    SEAM(0);

    if (IN(1)) for (int rep = 0; rep < PROBE_P1; ++rep) { PHASE_IDS
        constexpr int RB = 4;
        for (int m0 = gw * RB; m0 < M; m0 += NGW * RB) {
            const float* mod = MOD + (size_t)(m0 >> 13) * (6 * DM);
            f32x4 v[RB][8];
#pragma unroll
            for (int r = 0; r < RB; ++r) { const f32x4* xr = (const f32x4*)(a.x + (size_t)(m0 + r) * DM) + lane;
#pragma unroll
                for (int j = 0; j < 8; ++j) v[r][j] = __builtin_nontemporal_load(xr + 64 * j); }
#pragma unroll
            for (int r = 0; r < RB; ++r) {
                float s = 0.f;
#pragma unroll
                for (int j = 0; j < 8; ++j) s += (v[r][j].x + v[r][j].y) + (v[r][j].z + v[r][j].w);
                const float mean = wave_sum(s) * (1.f / DM); float s2 = 0.f;
#pragma unroll
                for (int j = 0; j < 8; ++j) { v[r][j] = v[r][j] - mean; s2 += (v[r][j].x * v[r][j].x + v[r][j].y * v[r][j].y) + (v[r][j].z * v[r][j].z + v[r][j].w * v[r][j].w); }
                const float rstd = 1.f / sqrtf(wave_sum(s2) * (1.f / DM) + LN_EPS);
                v2u* o8 = (v2u*)(H + (size_t)(m0 + r) * DM) + lane;
#pragma unroll
                for (int j = 0; j < 8; ++j) { const int col = 4 * (lane + 64 * j); const f32x4 sh = *(const f32x4*)(mod + col), sc = *(const f32x4*)(mod + DM + col);
                    const f32x4 h = v[r][j] * rstd * (sc + 1.f) + sh; v2u w; w.x = pk2(h.x, h.y); w.y = pk2(h.z, h.w); o8[64 * j] = w; }
            }
        }
    }
    SEAM(1);

    if (IN(2)) for (int rep = 0; rep < PROBE_GEMM; ++rep) {
        pg8::Gemm g{H, WIN, DM, M, NPROJ, DM}; pg8::StaticOrder S; S.init(M, NPROJ, G, (int)blockIdx.x);
        pg8::EpiInProj E{PROJ, NPROJ, a.b_gates};
        pg8::gemm_phase<pg8::EpiInProj>((LAS unsigned char*)lds, g, S, E, wave_s);
        { PHASE_IDS
          constexpr int NU = (M / 256) * (NPROJ / 256), I_G = 32 * 176, I_DN = 88 * 64, NFFN = 2 * I_G + I_DN;
          const int rem = NU % G; const bool idle = (rem == 0) || ((int)blockIdx.x >= rem);
          const int nidle = (rem == 0) ? G : (G - rem), me = (rem == 0) ? (int)blockIdx.x : ((int)blockIdx.x - rem);
          if (idle) { LAS float* scr = (LAS float*)((LAS unsigned char*)lds + wave * 16384);
            for (int it = me * NWAVES + wave; it < NFFN; it += nidle * NWAVES) { int r = it;
              if (r < I_G) { const int kb = r / 176, nb = r % 176, n0 = nb * 32; tr_item(a.w_ffn_gate, DFF, kb * 64, n0, WGU, DM, (n0 >> 7) * 256 + (n0 & 127), nullptr, false, scr, lane); continue; }
              r -= I_G;
              if (r < I_G) { const int kb = r / 176, nb = r % 176, n0 = nb * 32; tr_item(a.w_ffn_up, DFF, kb * 64, n0, WGU, DM, (n0 >> 7) * 256 + 128 + (n0 & 127), nullptr, false, scr, lane); continue; }
              r -= I_G;
              { const int kb = r / 64, nb = r % 64; tr_item(a.w_ffn_down, DM, kb * 64, nb * 32, WDN, DFF, nb * 32, nullptr, false, scr, lane); } } } }
    }
    SEAM(2);

    if (IN(3)) { PHASE_IDS
        float nq2 = 0.f, nk2 = 0.f, nkr2 = 0.f;
        for (int m = gw; m < M; m += NGW) {
            bf16* pr = PROJ + (size_t)m * NPROJ; const int tp = m & (SEQ - 1), prow = tp >> 6, pcol = tp & 63;
            const int half = lane >> 5, l = lane & 31;
            v2u hw[5];
#pragma unroll
            for (int it = 0; it < 5; ++it) hw[it] = *((const v2u*)(pr + (2 * it + half) * 128) + l);
            const v4u lw0 = *((const v4u*)(pr + PC_QLAT) + lane * 2), lw1 = *((const v4u*)(pr + PC_QLAT) + lane * 2 + 1);
            unsigned kw = 0; if (lane < 32) kw = *((const unsigned*)(pr + PC_KR) + lane);
            const int i0 = 2 * l, pos = (i0 < 32) ? prow : pcol, f0 = i0 & 31;
            const float c0 = CGt[pos * 32 + f0], s0 = SGt[pos * 32 + f0], c1 = CGt[pos * 32 + f0 + 1], s1 = SGt[pos * 32 + f0 + 1];
            const f32x4 gq = *(const f32x4*)(a.gqa_q_gain + 4 * l), gk = *(const f32x4*)(a.gqa_k_gain + 4 * l);
#pragma unroll
            for (int it = 0; it < 5; ++it) {
                const int hd = 2 * it + half; const v2u w = hw[it];
                float x0 = bflo(w.x), x1 = bfhi(w.x), x2 = bflo(w.y), x3 = bfhi(w.y);
                float ss = (x0 * x0 + x1 * x1) + (x2 * x2 + x3 * x3);
#pragma unroll
                for (int o = 1; o < 32; o <<= 1) ss += __shfl_xor(ss, o);
                const float rinv = 1.f / sqrtf(ss * (1.f / 128.f) + RMS_EPS);
                const f32x4 gv = (hd < 8) ? gq : gk; const float pre = (hd < 8) ? CG_PRE : 1.f;
                x0 *= rinv * gv.x * pre; x1 *= rinv * gv.y * pre; x2 *= rinv * gv.z * pre; x3 *= rinv * gv.w * pre;
                { float n2 = (x0 * x0 + x1 * x1) + (x2 * x2 + x3 * x3);
#pragma unroll
                  for (int o = 1; o < 32; o <<= 1) n2 += __shfl_xor(n2, o);
                  if (hd < 8) nq2 = fmaxf(nq2, n2); else nk2 = fmaxf(nk2, n2); }
                v2u o; o.x = pk2(x0 * c0 - x1 * s0, x0 * s0 + x1 * c0); o.y = pk2(x2 * c1 - x3 * s1, x2 * s1 + x3 * c1); *((v2u*)(pr + hd * 128) + l) = o;
            }
            {
                float ss = 0.f;
#pragma unroll
                for (int j = 0; j < 2; ++j) { const v4u w = j ? lw1 : lw0;
                    ss += bflo(w.x) * bflo(w.x) + bfhi(w.x) * bfhi(w.x) + bflo(w.y) * bflo(w.y) + bfhi(w.y) * bfhi(w.y)
                        + bflo(w.z) * bflo(w.z) + bfhi(w.z) * bfhi(w.z) + bflo(w.w) * bflo(w.w) + bfhi(w.w) * bfhi(w.w); }
#pragma unroll
                for (int o = 1; o < 32; o <<= 1) ss += __shfl_xor(ss, o);
                const float rinv = 1.f / sqrtf(ss * (1.f / 512.f) + RMS_EPS);
                if (l == 0) { if (half == 0) RINVQ[m] = rinv; else RINVKV[m] = rinv; }
            }
            { float kr2 = bflo(kw) * bflo(kw) + bfhi(kw) * bfhi(kw);
#pragma unroll
              for (int o = 1; o < 32; o <<= 1) kr2 += __shfl_xor(kr2, o);
              nkr2 = fmaxf(nkr2, kr2); }
            if (lane < 32) {
                const float x0 = bflo(kw), x1 = bfhi(kw);
                const int pos2 = (lane < 16) ? prow : pcol, f = lane & 15; const float c = CMt[pos2 * 16 + f], sn = SMt[pos2 * 16 + f];
                *((unsigned*)(pr + PC_KR) + lane) = pk2(x0 * c - x1 * sn, x0 * sn + x1 * c);
            }
        }
        nq2 = fmaxf(nq2, __shfl_xor(nq2, 32)); nk2 = fmaxf(nk2, __shfl_xor(nk2, 32));
        if (lane == 0) { atomicMax(NRM + 0, __float_as_uint(nq2)); atomicMax(NRM + 1, __float_as_uint(nk2)); atomicMax(NRM + 5, __float_as_uint(nkr2 * 1.02f)); }
    }
    SEAM(3);

    if (IN(4)) for (int rep = 0; rep < PROBE_GEMM; ++rep) {
        { pg8::Gemm g{PROJ + PC_QLAT, WUQ, NPROJ, M, 1536, 512}; pg8::StaticOrder S; S.init(M, 1536, G, (int)blockIdx.x);
          pg8::EpiQM E{QM, 1536, RINVQ, CM_PRE, CMt, SMt, NRM + 2}; pg8::gemm_phase<pg8::EpiQM>((LAS unsigned char*)lds, g, S, E, wave_s); }
        { pg8::Gemm g{PROJ + PC_KVLAT, WUKV, NPROJ, M, 2048, 512}; pg8::StaticOrder S; S.init(M, 2048, G, (int)blockIdx.x);
          pg8::EpiKVNorm E{KV, 2048, RINVKV, NRM + 4}; pg8::gemm_phase<pg8::EpiKVNorm>((LAS unsigned char*)lds, g, S, E, wave_s); }
    }
    SEAM(4);


    if (IN(6)) for (int rep = 0; rep < PROBE_REP6; ++rep) {
#ifndef ATT_ONLY
#define ATT_ONLY 3
#endif
#ifndef GQA_QREG
#define GQA_QREG 8
#endif
#ifndef GQA_SD
#define GQA_SD 2
#endif
#ifndef MLA_QREG_SAFE
#define MLA_QREG_SAFE 12
#endif
#ifndef GQA_QREG_SAFE
#define GQA_QREG_SAFE 8
#endif
#ifndef ATT_FN
#define ATT_FN attn_unit_stag
#endif
#ifndef MLA_SD
#define MLA_SD 1
#endif
#ifndef MLA_QREG
#define MLA_QREG 12
#endif
        const float bnd_g = sqrtf(__uint_as_float(__hip_atomic_load(NRM + 0, __ATOMIC_RELAXED, __HIP_MEMORY_SCOPE_AGENT)) * __uint_as_float(__hip_atomic_load(NRM + 1, __ATOMIC_RELAXED, __HIP_MEMORY_SCOPE_AGENT)));
        const float bnd_m = sqrtf(6.f * __uint_as_float(__hip_atomic_load(NRM + 2, __ATOMIC_RELAXED, __HIP_MEMORY_SCOPE_AGENT)) *
                                  (4.f * __uint_as_float(__hip_atomic_load(NRM + 4, __ATOMIC_RELAXED, __HIP_MEMORY_SCOPE_AGENT)) + __uint_as_float(__hip_atomic_load(NRM + 5, __ATOMIC_RELAXED, __HIP_MEMORY_SCOPE_AGENT))));
        const bool fast_g = __builtin_amdgcn_readfirstlane((int)(bnd_g < 96.f)) != 0, fast_m = __builtin_amdgcn_readfirstlane((int)(bnd_m < 96.f)) != 0;
#define MLA_ARGS QM + (r0 + slot * 256) * 1536 + h * 192, KV + r0 * 2048 + h * 256, PROJ + r0 * NPROJ + PC_KR, KV + r0 * 2048 + h * 256 + 128, YATT + (r0 + slot * 256) * 2048 + 1024 + h * 128, SEQ, (char*)lds, (LAS unsigned char*)lds, (const char*)ws, wave_s
#define MLA_ARGS_OLD QM + (r0 + slot * 256) * 1536 + h * 192, KV + r0 * 2048 + h * 256, PROJ + r0 * NPROJ + PC_KR, KV + r0 * 2048 + h * 256 + 128, YATT + (r0 + slot * 256) * 2048 + 1024 + h * 128, SEQ, (char*)lds, wave_s
#define GQA_ARGS_OLD PROJ + (r0 + slot * 256) * NPROJ + PC_QG + h * 128, PROJ + r0 * NPROJ + PC_KG + kvh * 128, nullptr, PROJ + r0 * NPROJ + PC_VG + kvh * 128, YATT + (r0 + slot * 256) * 2048 + h * 128, SEQ, (char*)lds, wave_s
#define GQA_ARGS PROJ + (r0 + slot * 256) * NPROJ + PC_QG + h * 128, PROJ + r0 * NPROJ + PC_KG + kvh * 128, nullptr, PROJ + r0 * NPROJ + PC_VG + kvh * 128, YATT + (r0 + slot * 256) * 2048 + h * 128, SEQ, (char*)lds, (LAS unsigned char*)lds, (const char*)ws, wave_s
        if (ATT_ONLY & 1) {
          if (fast_m) { for (int u = blockIdx.x; u < 1024; u += G) { const int xcd = u & 7, slot = (u >> 3) & 31, k = u >> 8; const int b = k, h = xcd; const size_t r0 = (size_t)b * SEQ;
              att::attn_unit_stag<192, MLA_QREG, true, 1536, 2048, NPROJ, 2048, 2048>(MLA_ARGS); } }
          else { for (int u = blockIdx.x; u < 1024; u += G) { const int xcd = u & 7, slot = (u >> 3) & 31, k = u >> 8; const int b = k, h = xcd; const size_t r0 = (size_t)b * SEQ;
              att::attn_unit<192, 8, 1, 1536, 2048, NPROJ, 2048, 2048>(MLA_ARGS_OLD); } }
        }
        if (ATT_ONLY & 2) {
          if (fast_g) { for (int u = blockIdx.x; u < 1024; u += G) { const int xcd = u & 7, slot = (u >> 3) & 31, k = u >> 8; const int b = xcd >> 1, kvh = xcd & 1, h = kvh * 4 + k; const size_t r0 = (size_t)b * SEQ;
              att::attn_unit_stag<128, GQA_QREG, true, NPROJ, NPROJ, NPROJ, NPROJ, 2048>(GQA_ARGS); } }
          else { for (int u = blockIdx.x; u < 1024; u += G) { const int xcd = u & 7, slot = (u >> 3) & 31, k = u >> 8; const int b = xcd >> 1, kvh = xcd & 1, h = kvh * 4 + k; const size_t r0 = (size_t)b * SEQ;
              att::attn_unit<128, 7, 2, NPROJ, NPROJ, NPROJ, NPROJ, 2048>(GQA_ARGS_OLD); } }
        }
#undef MLA_ARGS
#undef GQA_ARGS
    }
    SEAM(6);

    if (IN(7)) for (int rep = 0; rep < PROBE_GEMM; ++rep) {
        { pg8::Gemm g{YATT, WBG, 2048, M, DM, 2048}; pg8::StaticOrder S; S.init(M, DM, G, (int)blockIdx.x);
          pg8::EpiGateMerge E{H, DM, PROJ + PC_GATE, PROJ + PC_GATE + DM, NPROJ}; pg8::gemm_phase<pg8::EpiGateMerge>((LAS unsigned char*)lds, g, S, E, wave_s); }
    }
    SEAM(7);

    if (IN(8)) for (int rep = 0; rep < PROBE_GEMM; ++rep) {
        pg8::Gemm g{H, WOUT, DM, M, DM, DM}; pg8::StaticOrder S; S.init(M, DM, G, (int)blockIdx.x);
        pg8::EpiRowScale E{YATT, DM, nullptr, 1.f}; pg8::gemm_phase<pg8::EpiRowScale>((LAS unsigned char*)lds, g, S, E, wave_s);
    }
    SEAM(8);

    if (IN(9)) { PHASE_IDS
        constexpr int RB = 2;
        for (int m0 = gw * RB; m0 < M; m0 += NGW * RB) {
            const float* mod = MOD + (size_t)(m0 >> 13) * (6 * DM);
            f32x4 v[RB][8];
            v2u uu[RB][8];
#pragma unroll
            for (int r = 0; r < RB; ++r) { const f32x4* xr = (const f32x4*)(a.x + (size_t)(m0 + r) * DM) + lane; const v2u* ur = (const v2u*)(YATT + (size_t)(m0 + r) * DM) + lane;
#pragma unroll
                for (int j = 0; j < 8; ++j) { v[r][j] = __builtin_nontemporal_load(xr + 64 * j); uu[r][j] = ur[64 * j]; } }
#pragma unroll
            for (int r = 0; r < RB; ++r) {
                f32x4* xr = (f32x4*)(a.out + (size_t)(m0 + r) * DM) + lane;
                float s = 0.f;
#pragma unroll
                for (int j = 0; j < 8; ++j) { const f32x4 g1 = *(const f32x4*)(mod + 2 * DM + 4 * (lane + 64 * j)); const v2u w = uu[r][j];
                    v[r][j] = v[r][j] * ALPHA + g1 * (f32x4){bflo(w.x), bfhi(w.x), bflo(w.y), bfhi(w.y)};
                    s += (v[r][j].x + v[r][j].y) + (v[r][j].z + v[r][j].w); }
                float mean = wave_sum(s) * (1.f / DM), s2 = 0.f;
#pragma unroll
                for (int j = 0; j < 8; ++j) { v[r][j] = v[r][j] - mean; s2 += (v[r][j].x * v[r][j].x + v[r][j].y * v[r][j].y) + (v[r][j].z * v[r][j].z + v[r][j].w * v[r][j].w); }
                float rstd = 1.f / sqrtf(wave_sum(s2) * (1.f / DM) + LN_EPS);
                s = 0.f;
#pragma unroll
                for (int j = 0; j < 8; ++j) { const int col = 4 * (lane + 64 * j); const f32x4 gg = *(const f32x4*)(a.ln1_g + col), bb = *(const f32x4*)(a.ln1_b + col);
                    v[r][j] = v[r][j] * rstd * gg + bb; xr[64 * j] = v[r][j]; s += (v[r][j].x + v[r][j].y) + (v[r][j].z + v[r][j].w); }
                mean = wave_sum(s) * (1.f / DM); s2 = 0.f;
#pragma unroll
                for (int j = 0; j < 8; ++j) { v[r][j] = v[r][j] - mean; s2 += (v[r][j].x * v[r][j].x + v[r][j].y * v[r][j].y) + (v[r][j].z * v[r][j].z + v[r][j].w * v[r][j].w); }
                rstd = 1.f / sqrtf(wave_sum(s2) * (1.f / DM) + LN_EPS);
                v2u* o8 = (v2u*)(H + (size_t)(m0 + r) * DM) + lane;
#pragma unroll
                for (int j = 0; j < 8; ++j) { const int col = 4 * (lane + 64 * j); const f32x4 sh = *(const f32x4*)(mod + 3 * DM + col), sc = *(const f32x4*)(mod + 4 * DM + col);
                    const f32x4 h = v[r][j] * rstd * (sc + 1.f) + sh; v2u w; w.x = pk2(h.x, h.y); w.y = pk2(h.z, h.w); o8[64 * j] = w; }
            }
        }
    }
    SEAM(9);

    if (IN(10)) for (int rep = 0; rep < PROBE_REP10; ++rep) {
        pg8::Gemm g{H, WGU, DM, M, 2 * DFF, DM}; pg8::StaticOrder S; S.init(M, 2 * DFF, G, (int)blockIdx.x);
        pg8::EpiSwiGLU E{ACT, DFF}; pg8::gemm_phase<pg8::EpiSwiGLU>((LAS unsigned char*)lds, g, S, E, wave_s);
    }
    SEAM(10);

    if (IN(11)) for (int rep = 0; rep < PROBE_GEMM; ++rep) {
        pg8::Gemm g{ACT, WDN, DFF, M, DM, DFF}; pg8::StaticOrder S; S.init(M, DM, G, (int)blockIdx.x);
        pg8::EpiRowScale E{KV, DM, nullptr, 1.f}; pg8::gemm_phase<pg8::EpiRowScale>((LAS unsigned char*)lds, g, S, E, wave_s);
    }
    SEAM(11);
    if (IN(12)) { PHASE_IDS
        constexpr int RB = 2;
        for (int m0 = gw * RB; m0 < M; m0 += NGW * RB) {
            f32x4 v[RB][8];
            const float* mod = MOD + (size_t)(m0 >> 13) * (6 * DM);
            v2u uu[RB][8];
#pragma unroll
            for (int r = 0; r < RB; ++r) { const f32x4* xr = (const f32x4*)(a.out + (size_t)(m0 + r) * DM) + lane; const v2u* ur = (const v2u*)(KV + (size_t)(m0 + r) * DM) + lane;
#pragma unroll
                for (int j = 0; j < 8; ++j) { v[r][j] = xr[64 * j]; uu[r][j] = ur[64 * j]; } }
#pragma unroll
            for (int r = 0; r < RB; ++r) {
                f32x4* xr = (f32x4*)(a.out + (size_t)(m0 + r) * DM) + lane;
                float s = 0.f;
#pragma unroll
                for (int j = 0; j < 8; ++j) { const f32x4 g2 = *(const f32x4*)(mod + 5 * DM + 4 * (lane + 64 * j)); const v2u w = uu[r][j];
                    v[r][j] = v[r][j] * ALPHA + g2 * (f32x4){bflo(w.x), bfhi(w.x), bflo(w.y), bfhi(w.y)};
                    s += (v[r][j].x + v[r][j].y) + (v[r][j].z + v[r][j].w); }
                const float mean = wave_sum(s) * (1.f / DM); float s2 = 0.f;
#pragma unroll
                for (int j = 0; j < 8; ++j) { v[r][j] = v[r][j] - mean; s2 += (v[r][j].x * v[r][j].x + v[r][j].y * v[r][j].y) + (v[r][j].z * v[r][j].z + v[r][j].w * v[r][j].w); }
                const float rstd = 1.f / sqrtf(wave_sum(s2) * (1.f / DM) + LN_EPS);
#pragma unroll
                for (int j = 0; j < 8; ++j) { const int col = 4 * (lane + 64 * j); const f32x4 gg = *(const f32x4*)(a.ln2_g + col), bb = *(const f32x4*)(a.ln2_b + col);
                    __builtin_nontemporal_store(v[r][j] * rstd * gg + bb, xr + 64 * j); }
            }
        }
    }
#undef IN
#undef SEAM
}

extern "C" void kernel_launch(void* const* d_in, const int* in_sizes, int n_in, void* d_out, int out_size, void* d_ws, size_t ws_size, hipStream_t stream) {
    static int grid = 0;
    if (grid == 0) {
        if (n_in != 22 || in_sizes[0] != M * DM || out_size != M * DM || ws_size < WS_END) {
            fprintf(stderr, "kernel_launch: unexpected shapes: n_in %d in0 %d out %d ws %zu (need >= %zu)\n", n_in, n_in > 0 ? in_sizes[0] : -1, out_size, ws_size, (size_t)WS_END); grid = -1; return; }
        int dev = 0, cus = 0, per_cu = 0;
        if (hipGetDevice(&dev) != hipSuccess || hipDeviceGetAttribute(&cus, hipDeviceAttributeMultiprocessorCount, dev) != hipSuccess) { grid = -1; return; }
        if (hipFuncSetAttribute((const void*)mk_fwd, hipFuncAttributeMaxDynamicSharedMemorySize, LDS_BYTES) != hipSuccess) { fprintf(stderr, "kernel_launch: hipFuncSetAttribute failed\n"); grid = -1; return; }
        if (hipOccupancyMaxActiveBlocksPerMultiprocessor(&per_cu, (const void*)mk_fwd, NWAVES * 64, LDS_BYTES) != hipSuccess || per_cu < 1) { fprintf(stderr, "kernel_launch: occupancy query gave %d\n", per_cu); per_cu = 1; }
        (void)hipGetLastError();
        grid = cus * 1;
    }
    if (grid < 0) return;
    (void)hipMemsetAsync(d_ws, 0, WS_MOD + 4 * 6 * DM * sizeof(float), stream);
    Args a{};
    const float** f = (const float**)&a;
    for (int i = 0; i < 22; ++i) f[i] = (const float*)d_in[i];
    a.out = (float*)d_out; a.ws = (unsigned char*)d_ws;
#if MK_PER_PHASE
    for (int p = 0; p <= NPHASES; ++p) { a.ph_lo = p; a.ph_hi = p + 1; hipLaunchKernelGGL(mk_fwd, dim3(grid), dim3(NWAVES * 64), LDS_BYTES, stream, a); }
#else
    a.ph_lo = 0; a.ph_hi = NPHASES + 1;
    void* args[] = {&a};
    hipError_t e = hipLaunchCooperativeKernel((const void*)mk_fwd, dim3(grid), dim3(NWAVES * 64), args, LDS_BYTES, stream);
    if (e != hipSuccess) fprintf(stderr, "cooperative launch failed: %s (grid %d)\n", hipGetErrorString(e), grid);
#endif
}
```
